# Optimizing an MI355X kernel written in HIP

```python
import jax, jax.numpy as jnp
from jax import lax
import numpy as np

D_MODEL = 2048
BATCH = 4
SEQ = 4096
DEPTH = 1

RMS_EPS = 1e-5
ROPE_THETA = 10000.0
RET_HEADS = 8
RET_DK = 128
RET_DV = 256
RET_CHUNK = 128
SWA_Q_HEADS = 32
SWA_KV_HEADS = 4
SWA_HEAD_DIM = 64
SWA_WINDOW = 128
SWA_BLOCK = 128
N_EXPERTS = 32
TOP_K = 4
D_FF_EXPERT = 2048
SWIGLU_LIMIT = 7.0
SWIGLU_ALPHA = 1.702

N_BRANCHES = 2
RET_QK_W = RET_HEADS * RET_DK
RET_V_W = RET_HEADS * RET_DV
SWA_Q_W = SWA_Q_HEADS * SWA_HEAD_DIM
SWA_KV_W = SWA_KV_HEADS * SWA_HEAD_DIM
IN_SPLITS = (RET_QK_W, RET_QK_W, RET_V_W, RET_V_W, SWA_Q_W, SWA_KV_W, SWA_KV_W, N_BRANCHES * D_MODEL)
IN_WIDTH = sum(IN_SPLITS)

kernel_name = "hybrid_retention_swa_sink_moe"


def rms_norm(x, w):
    xf = x.astype(jnp.float32)
    y = xf * lax.rsqrt(jnp.mean(xf * xf, axis=-1, keepdims=True) + RMS_EPS)
    return (y * w.astype(jnp.float32)).astype(x.dtype)


def rope_tables(positions, head_dim):
    inv_freq = 1.0 / (ROPE_THETA ** (jnp.arange(0, head_dim, 2, dtype=jnp.float32) / head_dim))
    ang = positions.astype(jnp.float32)[..., None] * inv_freq
    return jnp.cos(ang), jnp.sin(ang)


def apply_rope(x, cos, sin):
    x1, x2 = jnp.split(x.astype(jnp.float32), 2, axis=-1)
    c = cos[:, :, None, :]
    s = sin[:, :, None, :]
    return jnp.concatenate([x1 * c - x2 * s, x2 * c + x1 * s], axis=-1)


def retention(q, k, v, g):
    B, S = q.shape[0], q.shape[1]
    C = RET_CHUNK
    nc = S // C
    H = RET_HEADS
    log_gamma = jnp.log1p(-jnp.exp2(-5.0 - jnp.arange(H, dtype=jnp.float32)))
    qc = q.astype(jnp.float32).reshape(B, nc, C, H, RET_DK)
    kc = (k.astype(jnp.float32) * (RET_DK ** -0.5)).reshape(B, nc, C, H, RET_DK)
    vc = v.astype(jnp.float32).reshape(B, nc, C, H, RET_DV)
    n = jnp.arange(C, dtype=jnp.float32)
    rel = n[:, None] - n[None, :]
    inner_decay = jnp.where(rel >= 0, jnp.exp(log_gamma[:, None, None] * jnp.maximum(rel, 0.0)), 0.0)
    scores = jnp.einsum('bnihd,bnjhd->bhnij', qc, kc) * inner_decay[:, None]
    inner = jnp.einsum('bhnij,bnjhe->bnihe', scores, vc)
    zeta = jnp.exp(log_gamma[:, None] * (C - 1 - n))
    u = jnp.einsum('bnjhd,bnjhe,hj->bnhde', kc, vc, zeta)
    chunk_decay = jnp.exp(log_gamma * C)[None, :, None, None]

    def step(state, u_i):
        return chunk_decay * state + u_i, state

    _, prev = lax.scan(step, jnp.zeros((B, H, RET_DK, RET_DV), jnp.float32), jnp.moveaxis(u, 1, 0))
    prev = jnp.moveaxis(prev, 0, 1)
    xi = jnp.exp(log_gamma[:, None] * (n + 1.0))
    cross = jnp.einsum('bnihd,bnhde,hi->bnihe', qc, prev, xi)
    o = (inner + cross).reshape(B, S, H, RET_DV)
    o = o * lax.rsqrt(jnp.mean(o * o, axis=-1, keepdims=True) + RMS_EPS)
    o = jax.nn.silu(g.astype(jnp.float32)) * o
    return o.reshape(B, S, H * RET_DV)


def sliding_window_attention(q, k, v, sinks):
    B, S = q.shape[0], q.shape[1]
    Wb = SWA_BLOCK
    nb = S // Wb
    G = SWA_Q_HEADS // SWA_KV_HEADS
    qb = q.reshape(B, nb, Wb, SWA_KV_HEADS, G, SWA_HEAD_DIM)

    def banded(t):
        tb = t.astype(jnp.float32).reshape(B, nb, Wb, SWA_KV_HEADS, SWA_HEAD_DIM)
        prev = jnp.concatenate([jnp.zeros_like(tb[:, :1]), tb[:, :-1]], axis=1)
        return jnp.concatenate([prev, tb], axis=2)

    kb, vb = banded(k), banded(v)
    s = jnp.einsum('bnikgd,bnjkd->bkgnij', qb, kb) * (SWA_HEAD_DIM ** -0.5)
    qi = jnp.arange(Wb)[:, None]
    kj = jnp.arange(2 * Wb)[None, :] - Wb
    dist = qi - kj
    in_window = (dist >= 0) & (dist < SWA_WINDOW)
    blk = jnp.arange(nb)[:, None, None]
    valid = in_window[None] & ((blk > 0) | (kj >= 0)[None])
    s = jnp.where(valid, s, -jnp.inf)
    sink = sinks.astype(jnp.float32).reshape(1, SWA_KV_HEADS, G, 1, 1, 1)
    m = jnp.maximum(jnp.max(s, axis=-1, keepdims=True), sink)
    p = jnp.exp(s - m)
    p = p / (jnp.sum(p, axis=-1, keepdims=True) + jnp.exp(sink - m))
    o = jnp.einsum('bkgnij,bnjkd->bnikgd', p, vb)
    return o.reshape(B, S, SWA_Q_HEADS * SWA_HEAD_DIM)


def moe_ffn(x, router_w, router_b, w_gate_up, b_gate_up, w_down, b_down):
    B, S, D = x.shape
    xt = x.reshape(B * S, D)
    logits = (xt @ router_w + router_b).astype(jnp.float32)
    top_vals, top_idx = lax.top_k(logits, TOP_K)
    top_w = jax.nn.softmax(top_vals, axis=-1)
    combine = jnp.einsum('nk,nke->ne', top_w, jax.nn.one_hot(top_idx, N_EXPERTS, dtype=jnp.float32))
    out = jnp.zeros((B * S, D), jnp.float32)
    for e in range(N_EXPERTS):
        hg = (xt @ w_gate_up[e] + b_gate_up[e]).astype(jnp.float32)
        gate = jnp.minimum(hg[:, 0::2], SWIGLU_LIMIT)
        lin = jnp.clip(hg[:, 1::2], -SWIGLU_LIMIT, SWIGLU_LIMIT)
        act = gate * jax.nn.sigmoid(SWIGLU_ALPHA * gate) * (lin + 1.0)
        y = act.astype(x.dtype) @ w_down[e] + b_down[e]
        out = out + combine[:, e:e + 1] * y.astype(jnp.float32)
    return out.reshape(B, S, D).astype(x.dtype)


def setup_inputs(seed: int = 0) -> dict:
    key = jax.random.key(seed)
    ks = jax.random.split(key, 20)
    f32 = jnp.float32
    L = DEPTH

    def nrm(k, shape, scale):
        return jax.random.normal(k, shape, f32) * scale

    x = nrm(ks[0], (BATCH, SEQ, D_MODEL), 1.0)
    offset = jax.random.randint(ks[1], (BATCH, 1), 0, 1024, dtype=jnp.int32)
    positions = offset + jnp.arange(SEQ, dtype=jnp.int32)[None, :]
    return {
        "x": x,
        "positions": positions,
        "attn_norm_w": 1.0 + nrm(ks[2], (L, D_MODEL), 0.02),
        "w_in": nrm(ks[3], (L, D_MODEL, IN_WIDTH), D_MODEL ** -0.5),
        "gate_bias": nrm(ks[4], (L, N_BRANCHES * D_MODEL), 0.02),
        "w_ret_out": nrm(ks[5], (L, RET_V_W, D_MODEL), RET_V_W ** -0.5),
        "w_swa_out": nrm(ks[6], (L, SWA_Q_W, D_MODEL), SWA_Q_W ** -0.5),
        "w_o": nrm(ks[7], (L, D_MODEL, D_MODEL), D_MODEL ** -0.5),
        "sinks": nrm(ks[8], (L, SWA_Q_HEADS), 0.5),
        "ffn_norm_w": 1.0 + nrm(ks[9], (L, D_MODEL), 0.02),
        "router_w": nrm(ks[10], (L, D_MODEL, N_EXPERTS), D_MODEL ** -0.5),
        "router_b": nrm(ks[11], (L, N_EXPERTS), 0.01),
        "w_gate_up": nrm(ks[12], (L, N_EXPERTS, D_MODEL, 2 * D_FF_EXPERT), D_MODEL ** -0.5),
        "b_gate_up": nrm(ks[13], (L, N_EXPERTS, 2 * D_FF_EXPERT), 0.01),
        "w_down": nrm(ks[14], (L, N_EXPERTS, D_FF_EXPERT, D_MODEL), D_FF_EXPERT ** -0.5),
        "b_down": nrm(ks[15], (L, N_EXPERTS, D_MODEL), 0.01),
        "final_norm_w": 1.0 + nrm(ks[16], (D_MODEL,), 0.02),
    }


def reference(x, positions, attn_norm_w, w_in, gate_bias, w_ret_out, w_swa_out, w_o, sinks,
              ffn_norm_w, router_w, router_b, w_gate_up, b_gate_up, w_down, b_down, final_norm_w):
    B, S, D = x.shape
    cos_r, sin_r = rope_tables(positions, RET_DK)
    cos_s, sin_s = rope_tables(positions, SWA_HEAD_DIM)
    split_at = [int(i) for i in np.cumsum(IN_SPLITS)[:-1]]
    h = x
    for l in range(DEPTH):
        xn = rms_norm(h, attn_norm_w[l])
        proj = xn @ w_in[l]
        rq, rk, rv, rg, sq, sk, sv, gl = jnp.split(proj, split_at, axis=-1)
        rq = apply_rope(rq.reshape(B, S, RET_HEADS, RET_DK), cos_r, sin_r)
        rk = apply_rope(rk.reshape(B, S, RET_HEADS, RET_DK), cos_r, sin_r)
        ret = retention(rq, rk, rv.reshape(B, S, RET_HEADS, RET_DV), rg.reshape(B, S, RET_HEADS, RET_DV))
        branch_a = ret.astype(x.dtype) @ w_ret_out[l]
        sq = apply_rope(sq.reshape(B, S, SWA_Q_HEADS, SWA_HEAD_DIM), cos_s, sin_s)
        sk = apply_rope(sk.reshape(B, S, SWA_KV_HEADS, SWA_HEAD_DIM), cos_s, sin_s)
        swa = sliding_window_attention(sq, sk, sv.reshape(B, S, SWA_KV_HEADS, SWA_HEAD_DIM), sinks[l])
        branch_b = swa.astype(x.dtype) @ w_swa_out[l]
        gates = jax.nn.sigmoid((gl + gate_bias[l]).astype(jnp.float32)).reshape(B, S, N_BRANCHES, D)
        mix = gates[:, :, 0] * branch_a.astype(jnp.float32) + gates[:, :, 1] * branch_b.astype(jnp.float32)
        h = h + mix.astype(x.dtype) @ w_o[l]
        h = h + moe_ffn(rms_norm(h, ffn_norm_w[l]), router_w[l], router_b[l],
                        w_gate_up[l], b_gate_up[l], w_down[l], b_down[l])
    return rms_norm(h, final_norm_w)
```

```cpp
#include <hip/hip_runtime.h>
#include <cstdio>
#include <cstdint>

#ifndef MK_N_LAUNCHES
#define MK_N_LAUNCHES 1
#endif

#define LAS __attribute__((address_space(3)))
#define GAS __attribute__((address_space(1)))
typedef unsigned short bf16_t;
typedef short bf16x8 __attribute__((ext_vector_type(8)));
typedef short s16x4 __attribute__((ext_vector_type(4)));
typedef float f32x2 __attribute__((ext_vector_type(2)));
typedef float f32x4 __attribute__((ext_vector_type(4)));
typedef float f32x16 __attribute__((ext_vector_type(16)));
typedef unsigned u32x2 __attribute__((ext_vector_type(2)));
typedef unsigned u32x4 __attribute__((ext_vector_type(4)));
typedef __bf16 bf16x2_t __attribute__((ext_vector_type(2)));

constexpr int NTOK = 16384, DM = 2048, SEQ = 4096, NB = 4;
constexpr int INW = 12800;
constexpr int NEXP = 32, DFF = 2048;
constexpr float RMS_EPS = 1e-5f;
constexpr float LOG2E = 1.4426950408889634f;
constexpr float C2 = 0.125f * LOG2E;
constexpr int MAXT = 320;

constexpr size_t MiB = 1u << 20;
constexpr size_t WS_CTL = 0, CTL_BYTES = 1 * MiB;
constexpr size_t WS_WIN_T = 1 * MiB;
constexpr size_t WS_WBR_T = WS_WIN_T + (size_t)INW * DM * 2;
constexpr size_t WS_WO_T  = WS_WBR_T + (size_t)2 * DM * DM * 2;
constexpr size_t WS_WGU_T = WS_WO_T + (size_t)DM * DM * 2;
constexpr size_t WS_WDN_T = WS_WGU_T + (size_t)NEXP * 2 * DFF * DM * 2;
constexpr size_t WS_XN    = WS_WDN_T + (size_t)NEXP * DM * DFF * 2;
constexpr size_t WS_RQ    = WS_XN + (size_t)NTOK * DM * 2;
constexpr size_t WS_RK    = WS_RQ + (size_t)NTOK * 1024 * 2;
constexpr size_t WS_RV    = WS_RK + (size_t)NTOK * 1024 * 2;
constexpr size_t WS_RG    = WS_RV + (size_t)NTOK * DM * 2;
constexpr size_t WS_SQ    = WS_RG + (size_t)NTOK * DM * 2;
constexpr size_t WS_SK    = WS_SQ + (size_t)NTOK * DM * 2;
constexpr size_t WS_SV    = WS_SK + (size_t)NTOK * 256 * 2;
constexpr size_t WS_GATES = WS_SV + (size_t)NTOK * 256 * 2;
constexpr size_t WS_COSR  = WS_GATES + (size_t)NTOK * 4096 * 2;
constexpr size_t WS_SINR  = WS_COSR + (size_t)NTOK * 64 * 4;
constexpr size_t WS_COSS  = WS_SINR + (size_t)NTOK * 64 * 4;
constexpr size_t WS_SINS  = WS_COSS + (size_t)NTOK * 32 * 4;
constexpr size_t WS_UT    = WS_SINS + (size_t)NTOK * 32 * 4;
constexpr size_t WS_PNT   = WS_UT + (size_t)NB * 32 * 8 * 256 * 128 * 4;
constexpr size_t WS_BR    = WS_PNT + (size_t)NB * 32 * 8 * 256 * 128 * 2;
constexpr size_t WS_MIX   = WS_BR + (size_t)2 * NTOK * DM * 2;
constexpr size_t WS_H2    = WS_MIX + (size_t)NTOK * DM * 2;
constexpr size_t WS_A2N   = WS_H2 + (size_t)NTOK * DM * 4;
constexpr size_t WS_TOKE  = WS_A2N + (size_t)NTOK * DM * 2;
constexpr size_t WS_TOKR  = WS_TOKE + (size_t)NTOK * 4 * 4;
constexpr size_t WS_TOKW  = WS_TOKR + (size_t)NTOK * 4 * 4;
constexpr size_t WS_LIST  = WS_TOKW + (size_t)NTOK * 4 * 4;
constexpr size_t WS_ACT   = WS_LIST + (size_t)NEXP * NTOK * 4;
constexpr size_t WS_Y     = WS_ACT + (size_t)MAXT * 256 * DFF * 2;
constexpr size_t WS_END   = WS_Y + (size_t)MAXT * 256 * DM * 2;

constexpr int CW_CNT = 64;
constexpr int CW_BAR = 4096;

constexpr int LDS_BYTES = 163840;
constexpr int MISC_OFF = 163840 - 4096;

__device__ __forceinline__ unsigned cvt_pk(float lo, float hi) { f32x2 v = {lo, hi}; bf16x2_t b = __builtin_convertvector(v, bf16x2_t); return __builtin_bit_cast(unsigned, b); }
__device__ __forceinline__ float bf_lo(unsigned w) { return __uint_as_float(w << 16); }
__device__ __forceinline__ float bf_hi(unsigned w) { return __uint_as_float(w & 0xffff0000u); }
__device__ __forceinline__ int crow(int r, int hi) { return (r & 3) + 8 * (r >> 2) + 4 * hi; }
__device__ __forceinline__ s16x4 tr16(LAS const unsigned char* p) { typedef short v4i16_t __attribute__((ext_vector_type(4))); return __builtin_bit_cast(s16x4, __builtin_amdgcn_ds_read_tr16_b64_v4i16((LAS v4i16_t*)p)); }
__device__ __forceinline__ bf16x8 mk8(s16x4 lo, s16x4 hi) { return (bf16x8){lo[0], lo[1], lo[2], lo[3], hi[0], hi[1], hi[2], hi[3]}; }
__device__ __forceinline__ float fast_sigmoid(float x) { return __builtin_amdgcn_rcpf(1.0f + __expf(-x)); }

namespace pg8 {
constexpr int BM = 256, BK = 64, HALF = 128, HTB = HALF * BK * 2, STAGE_BYTES = 8 * HTB, NXCD = 8, WGM = 8;
__host__ __device__ __forceinline__ int lds_byte(int r, int c) { const int st = (r >> 4) * 2 + (c >> 5), rr = r & 15, cc = c & 31, ob = rr * 64 + cc * 2; return st * 1024 + (ob ^ (((ob >> 9) & 1) << 5)); }
__host__ __device__ __forceinline__ void stage_rc(int b, int& R, int& C) { const int st = b / 1024, sb = b % 1024, swz = sb ^ (((sb >> 9) & 1) << 5); R = (st >> 1) * 16 + swz / 64; C = (st & 1) * 32 + (swz % 64) / 2; }
__host__ __device__ __forceinline__ int perm32(int rho) { const int n = rho >> 4, i = rho & 15; return 8 * (i >> 2) + 4 * n + (i & 3); }

struct Unit { int pm, pn; };

__device__ __forceinline__ bool tile_order(int L, int nM, int nN, int& pm, int& pn) {
    const int nwg = nM * nN; if (L >= nwg) return false;
    int wgid = L; { const int q = nwg / NXCD, r = nwg % NXCD, xcd = wgid % NXCD, off = wgid / NXCD; wgid = (xcd < r ? xcd * (q + 1) : r * (q + 1) + (xcd - r) * q) + off; }
    const int nig = WGM * nN, gid = wgid / nig, fm = gid * WGM, gsz = (nM - fm) < WGM ? (nM - fm) : WGM;
    pm = fm + ((wgid % nig) % gsz); pn = (wgid % nig) / gsz; return true;
}

template <class Epi, class Sched>
__device__ __forceinline__ void gemm_phase(LAS unsigned char* lds, const bf16_t* Ap, const bf16_t* Btp, const int K, const Sched& S, const Epi& E) {
    const int tid = threadIdx.x, wid = __builtin_amdgcn_readfirstlane(tid >> 6), lane = tid & 63, wr = wid >> 2, wc = wid & 3, fr = lane & 15, fq = lane >> 4;
    const int nt = K / BK;
    unsigned voffA[2], voffB[2]; int rA[2], cA2[2];
#pragma unroll
    for (int i = 0; i < 2; ++i) { int R, C; stage_rc(tid * 16 + i * 8192, R, C); const int Rb = Epi::PERM ? ((R & ~31) + perm32(R & 31)) : R;
        voffA[i] = (unsigned)(R * K + C) * 2u; voffB[i] = (unsigned)(Rb * K + C) * 2u; rA[i] = R; cA2[i] = C * 2; }
    const size_t kstep = (size_t)(BK * 2);
    const size_t hstep = (size_t)HALF * K * 2;
    const size_t tstep = 2 * hstep;
    const unsigned ldsw = (unsigned)wid * 1024u;
    const int aoff = lds_byte(wr * 64 + fr, fq * 8), boff = lds_byte(wc * 32 + fr, fq * 8);
#define PG8_SA(b, h) (((b) * 2 + (h)) * HTB)
#define PG8_SB(b, h) ((4 + (b) * 2 + (h)) * HTB)
#define PG8_STAGE(bufoff, gbase, v0, v1) do { \
        __builtin_amdgcn_global_load_lds((const unsigned*)((const char*)(gbase) + (v0)), (LAS unsigned*)(lds + (bufoff) + ldsw), 16, 0, 0); \
        __builtin_amdgcn_global_load_lds((const unsigned*)((const char*)(gbase) + (v1)), (LAS unsigned*)(lds + (bufoff) + ldsw + 8192), 16, 0, 0); } while (0)
#define PG8_LDA(dst, b, h) do { _Pragma("unroll") for (int m = 0; m < 4; ++m) _Pragma("unroll") for (int k = 0; k < 2; ++k) dst[m][k] = *(const LAS bf16x8*)(lds + PG8_SA(b, h) + aoff + m * 2048 + k * 1024); } while (0)
#define PG8_LDB(dst, b, h) do { _Pragma("unroll") for (int n = 0; n < 2; ++n) _Pragma("unroll") for (int k = 0; k < 2; ++k) dst[n][k] = *(const LAS bf16x8*)(lds + PG8_SB(b, h) + boff + n * 2048 + k * 1024); } while (0)
#define PG8_MMA(ai, bj, At, Bt) do { __builtin_amdgcn_s_setprio(1); _Pragma("unroll") for (int m = 0; m < 4; ++m) _Pragma("unroll") for (int n = 0; n < 2; ++n) _Pragma("unroll") for (int k = 0; k < 2; ++k) \
        acc[ai][bj][m][n] = __builtin_amdgcn_mfma_f32_16x16x32_bf16(Bt[n][k], At[m][k], acc[ai][bj][m][n], 0, 0, 0); __builtin_amdgcn_s_setprio(0); } while (0)
#define PG8_WAIT_V(n) asm volatile("s_waitcnt vmcnt(" #n ")" ::: "memory")
#define PG8_WAIT_L(n) asm volatile("s_waitcnt lgkmcnt(" #n ")" ::: "memory")
#define PG8_BAR __builtin_amdgcn_s_barrier()
#define PG8_SCHED __builtin_amdgcn_sched_barrier(0)
    Unit cur, nxt; int ui = 0;
    if (!S.next(0, cur)) return;
    f32x4 acc[2][2][4][2];
#pragma unroll
    for (int a = 0; a < 2; ++a)
#pragma unroll
        for (int b = 0; b < 2; ++b)
#pragma unroll
            for (int m = 0; m < 4; ++m)
#pragma unroll
                for (int n = 0; n < 2; ++n) acc[a][b][m][n] = (f32x4){0.f, 0.f, 0.f, 0.f};
    bf16x8 At[4][2], B0[2][2], B1[2][2];
    const char* cAb0; const char* cAb1; unsigned cA00, cA01, cA10, cA11;
    const char* nAb0; const char* nAb1; unsigned nA00, nA01, nA10, nA11;
#define PG8_ADESC(u, b0, b1, o00, o01, o10, o11) do { \
        if constexpr (Sched::GATHER) { b0 = (const char*)Ap; b1 = (const char*)Ap; \
            o00 = (unsigned)S.row_token(u, rA[0]) * (unsigned)(K * 2) + (unsigned)cA2[0]; o01 = (unsigned)S.row_token(u, rA[1]) * (unsigned)(K * 2) + (unsigned)cA2[1]; \
            o10 = (unsigned)S.row_token(u, HALF + rA[0]) * (unsigned)(K * 2) + (unsigned)cA2[0]; o11 = (unsigned)S.row_token(u, HALF + rA[1]) * (unsigned)(K * 2) + (unsigned)cA2[1]; } \
        else { b0 = (const char*)Ap + (size_t)(u).pm * tstep; b1 = b0 + hstep; o00 = voffA[0]; o01 = voffA[1]; o10 = voffA[0]; o11 = voffA[1]; } } while (0)
    PG8_ADESC(cur, cAb0, cAb1, cA00, cA01, cA10, cA11);
    const char* cB = (const char*)Btp + (size_t)cur.pn * tstep;
    PG8_STAGE(PG8_SB(0, 0), cB, voffB[0], voffB[1]); PG8_STAGE(PG8_SB(0, 1), cB + hstep, voffB[0], voffB[1]); PG8_STAGE(PG8_SA(0, 0), cAb0, cA00, cA01); PG8_STAGE(PG8_SA(0, 1), cAb1, cA10, cA11);
    if (wr == 1) PG8_BAR;
    PG8_WAIT_V(2); PG8_BAR;
    PG8_STAGE(PG8_SB(1, 0), cB + kstep, voffB[0], voffB[1]); PG8_STAGE(PG8_SA(1, 0), cAb0 + kstep, cA00, cA01); PG8_STAGE(PG8_SB(1, 1), cB + hstep + kstep, voffB[0], voffB[1]);
    PG8_WAIT_V(6); PG8_BAR;
    for (;;) {
        const bool has_next = S.next(ui + 1, nxt);
        if (has_next) { PG8_ADESC(nxt, nAb0, nAb1, nA00, nA01, nA10, nA11); } else { nAb0 = cAb0; nAb1 = cAb1; nA00 = cA00; nA01 = cA01; nA10 = cA10; nA11 = cA11; }
        const char* nB = has_next ? (const char*)Btp + (size_t)nxt.pn * tstep : cB;
        for (int t = 0; t < nt; t += 2) {
            const bool last = (t == nt - 2);
            const char* a1h1 = cAb1 + (size_t)(t + 1) * kstep;
            const char* a2h0 = last ? nAb0 : cAb0 + (size_t)(t + 2) * kstep; const char* a2h1 = last ? nAb1 : cAb1 + (size_t)(t + 2) * kstep;
            const unsigned x00 = last ? nA00 : cA00, x01 = last ? nA01 : cA01, x10 = last ? nA10 : cA10, x11 = last ? nA11 : cA11;
            const char* b2 = last ? nB : cB + (size_t)(t + 2) * kstep;
            const char* a3h0 = a2h0 + kstep; const char* b3 = b2 + kstep;
            PG8_LDB(B0, 0, 0); PG8_LDB(B1, 0, 1); PG8_SCHED; PG8_LDA(At, 0, 0); PG8_STAGE(PG8_SA(1, 1), a1h1, cA10, cA11);
            PG8_WAIT_V(8); PG8_WAIT_L(0); PG8_BAR; PG8_MMA(0, 0, At, B0); PG8_MMA(0, 1, At, B1); PG8_BAR; PG8_SCHED;
            PG8_LDA(At, 0, 1); PG8_STAGE(PG8_SB(0, 0), b2, voffB[0], voffB[1]); PG8_STAGE(PG8_SB(0, 1), b2 + hstep, voffB[0], voffB[1]); PG8_STAGE(PG8_SA(0, 0), a2h0, x00, x01);
            PG8_WAIT_V(8); PG8_WAIT_L(0); PG8_BAR; PG8_MMA(1, 0, At, B0); PG8_MMA(1, 1, At, B1); PG8_BAR; PG8_SCHED;
            PG8_LDB(B0, 1, 0); PG8_LDB(B1, 1, 1); PG8_SCHED; PG8_LDA(At, 1, 0); PG8_STAGE(PG8_SA(0, 1), a2h1, x10, x11);
            PG8_WAIT_V(8); PG8_WAIT_L(0); PG8_BAR; PG8_MMA(0, 0, At, B0); PG8_MMA(0, 1, At, B1); PG8_BAR; PG8_SCHED;
            PG8_LDA(At, 1, 1); PG8_STAGE(PG8_SB(1, 0), b3, voffB[0], voffB[1]); PG8_STAGE(PG8_SB(1, 1), b3 + hstep, voffB[0], voffB[1]); PG8_STAGE(PG8_SA(1, 0), a3h0, x00, x01);
            PG8_WAIT_V(8); PG8_WAIT_L(0); PG8_BAR; PG8_MMA(1, 0, At, B0); PG8_MMA(1, 1, At, B1); PG8_BAR; PG8_SCHED;
        }
        if (wr == 0) PG8_BAR;
        E(acc, cur, wr, wc, fr, fq);
        if (!has_next) break;
#pragma unroll
        for (int a = 0; a < 2; ++a)
#pragma unroll
            for (int b = 0; b < 2; ++b)
#pragma unroll
                for (int m = 0; m < 4; ++m)
#pragma unroll
                    for (int n = 0; n < 2; ++n) acc[a][b][m][n] = (f32x4){0.f, 0.f, 0.f, 0.f};
        cur = nxt; cAb0 = nAb0; cAb1 = nAb1; cA00 = nA00; cA01 = nA01; cA10 = nA10; cA11 = nA11; cB = nB; ++ui;
        if (wr == 1) PG8_BAR;
    }
    PG8_WAIT_V(0);
    PG8_BAR;
#undef PG8_ADESC
#undef PG8_SA
#undef PG8_SB
#undef PG8_STAGE
#undef PG8_LDA
#undef PG8_LDB
#undef PG8_MMA
#undef PG8_WAIT_V
#undef PG8_WAIT_L
#undef PG8_BAR
#undef PG8_SCHED
}
}
using pg8::Unit;

#define XB_TMO      128
#define XB_XCNT(j)  (256  + 64 * (j))
#define XB_XSUB(j)  (1280 + 64 * (j))
#define XB_XGEN(j)  (2304 + 64 * (j))
#define XB_TOP      3328
#define XB_TOPGEN   3392
#define XCD_BAR_WORDS 3456
#define XB_SPIN_CAP (1u << 18)

__device__ __forceinline__ unsigned xb_ld(unsigned* p)              { return __hip_atomic_load(p, __ATOMIC_RELAXED, __HIP_MEMORY_SCOPE_AGENT); }
__device__ __forceinline__ unsigned xb_add(unsigned* p, unsigned v) { return __hip_atomic_fetch_add(p, v, __ATOMIC_RELAXED, __HIP_MEMORY_SCOPE_AGENT); }
__device__ __forceinline__ unsigned xb_xcc_id() { return (unsigned)__builtin_amdgcn_s_getreg((3 << 11) | 20) & 0xFu; }
#define XB_SPIN(cond, bar) do { unsigned _sp = 0; while (cond) { __builtin_amdgcn_s_sleep(1); \
    if ((++_sp & 255u) == 0u) { if (xb_ld(&(bar)[XB_TMO])) break; if (_sp > XB_SPIN_CAP) { atomicAdd(&(bar)[XB_TMO], 1u); break; } } } } while (0)

struct XcdBarrier { unsigned* bar; unsigned x; volatile LAS unsigned* st; };

__device__ __forceinline__ XcdBarrier xcd_barrier_post(unsigned* bar, volatile LAS unsigned* st) {
    XcdBarrier b; b.bar = bar; b.x = xb_xcc_id(); b.st = st;
    if (threadIdx.x == 0) (void)xb_add(&bar[XB_XCNT(b.x)], 1u);
    return b;
}
__device__ __forceinline__ void xcd_barrier_complete(unsigned* bar, unsigned x, unsigned& nloc, unsigned& nx) {
    const unsigned G = gridDim.x * gridDim.y * gridDim.z;
    unsigned sum, cnt, mine, sp = 0u;
    for (;;) {
        sum = 0u; cnt = 0u; mine = 0u;
#pragma unroll
        for (unsigned j = 0; j < 16; ++j) { const unsigned c = xb_ld(&bar[XB_XCNT(j)]); sum += c; cnt += (c > 0u) ? 1u : 0u; mine = (j == x) ? c : mine; }
        if (sum == G) break;
        __builtin_amdgcn_s_sleep(1);
        if ((++sp & 255u) == 0u) { if (xb_ld(&bar[XB_TMO])) break; if (sp > XB_SPIN_CAP) { atomicAdd(&bar[XB_TMO], 1u); break; } }
    }
    nloc = mine > 0u ? mine : 1u; nx = cnt > 0u ? cnt : 1u;
}
__device__ __forceinline__ void xcd_barrier(const XcdBarrier& b) {
    asm volatile("s_waitcnt vmcnt(0)" ::: "memory");
    __syncthreads();
    if (threadIdx.x == 0) {
        unsigned* bar = b.bar;
        __builtin_amdgcn_s_waitcnt(0);
        unsigned nloc = b.st[0], nx = b.st[1];
        if (nloc == 0u) { xcd_barrier_complete(bar, b.x, nloc, nx); b.st[0] = nloc; b.st[1] = nx; }
        const unsigned old = xb_add(&bar[XB_XSUB(b.x)], 1u);
        const unsigned gen = old / nloc;
        if (old + 1u == (gen + 1u) * nloc) {
            __builtin_amdgcn_fence(__ATOMIC_RELEASE, "agent");
            asm volatile("s_waitcnt vmcnt(0)" ::: "memory");
            const unsigned og = xb_add(&bar[XB_TOP], 1u);
            const unsigned tg = og / nx;
            if (og + 1u == (tg + 1u) * nx) xb_add(&bar[XB_TOPGEN], 1u);
            else XB_SPIN(xb_ld(&bar[XB_TOPGEN]) == tg, bar);
            __builtin_amdgcn_fence(__ATOMIC_ACQUIRE, "agent");
            xb_add(&bar[XB_XGEN(b.x)], 1u);
            asm volatile("s_waitcnt vmcnt(0)" ::: "memory");
        } else {
            XB_SPIN(xb_ld(&bar[XB_XGEN(b.x)]) == gen, bar);
            __builtin_amdgcn_fence(__ATOMIC_ACQUIRE, "agent");
            asm volatile("s_waitcnt vmcnt(0)" ::: "memory");
        }
    }
    __syncthreads();
}

struct Params {
    const float* x; const int* positions; const float* attn_norm_w; const float* w_in; const float* gate_bias; const float* w_ret_out; const float* w_swa_out; const float* w_o;
    const float* sinks; const float* ffn_norm_w; const float* router_w; const float* router_b; const float* w_gate_up; const float* b_gate_up; const float* w_down; const float* b_down;
    const float* final_norm_w; float* out; unsigned char* ws; int ph_lo, ph_hi;
};

struct StaticOrder {
    static constexpr bool GATHER = false;
    int nM, nN, G, c;
    __device__ __forceinline__ bool next(int i, Unit& u) const { return pg8::tile_order(i * G + c, nM, nN, u.pm, u.pn); }
    __device__ __forceinline__ int row_token(const Unit&, int) const { return 0; }
};
struct MixOrder {
    static constexpr bool GATHER = false;
    int G, c;
    __device__ __forceinline__ bool next(int i, Unit& u) const { int pm, pn; if (!pg8::tile_order((i >> 1) * G + c, 64, 8, pm, pn)) return false; const int br = i & 1; u.pm = br * 64 + pm; u.pn = br * 8 + pn; return true; }
    __device__ __forceinline__ int row_token(const Unit&, int) const { return 0; }
};
template <bool GATH> struct MoeOrder {
    static constexpr bool GATHER = GATH;
    int T, nN, G, c; const LAS int* cnt; const LAS int* tile0; const LAS int* mte; const int* list;
    __device__ __forceinline__ bool next(int i, Unit& u) const { int pm, pn; if (!pg8::tile_order(i * G + c, T, nN, pm, pn)) return false; const int e = __builtin_amdgcn_readfirstlane(mte[pm]); u.pm = pm; u.pn = e * nN + pn; return true; }
    __device__ __forceinline__ int row_token(const Unit& u, int row) const {
        const int e = u.pn / nN; const int t0 = __builtin_amdgcn_readfirstlane(tile0[e]), ce = __builtin_amdgcn_readfirstlane(cnt[e]);
        const int rank = (u.pm - t0) * 256 + row; return rank < ce ? list[e * NTOK + rank] : 0; }
};

struct EpiProj {
    static constexpr bool PERM = true;
    unsigned char* ws; const float* gate_bias;
    __device__ __forceinline__ void operator()(const f32x4 (&acc)[2][2][4][2], const Unit& u, int wr, int wc, int fr, int fq) const {
        const int ct = u.pn; const int row0 = u.pm * 256 + wr * 64 + fr; const int cw = wc * 32 + 8 * fq;
        if (ct < 8) {
            bf16_t* dst = (bf16_t*)(ws + (ct < 4 ? WS_RQ : WS_RK)); const int colt = (ct & 3) * 256; const float sc = ct < 4 ? 1.0f : 0.08838834764831845f; const int f0 = 16 * wc + 4 * fq;
            const float* cosr = (const float*)(ws + WS_COSR); const float* sinr = (const float*)(ws + WS_SINR);
#pragma unroll
            for (int ai = 0; ai < 2; ++ai)
#pragma unroll
                for (int m = 0; m < 4; ++m) { const int row = row0 + ai * 128 + m * 16;
                    const f32x4 c = *(const f32x4*)(cosr + (size_t)row * 64 + f0) * sc, s = *(const f32x4*)(sinr + (size_t)row * 64 + f0) * sc;
#pragma unroll
                    for (int bj = 0; bj < 2; ++bj) { const f32x4 v0 = acc[ai][bj][m][0], v1 = acc[ai][bj][m][1]; const f32x4 o1 = v0 * c - v1 * s, o2 = v1 * c + v0 * s;
                        u32x4 w; w.x = cvt_pk(o1[0], o1[1]); w.y = cvt_pk(o1[2], o1[3]); w.z = cvt_pk(o2[0], o2[1]); w.w = cvt_pk(o2[2], o2[3]);
                        *(u32x4*)(dst + (size_t)row * 1024 + colt + bj * 128 + cw) = w; } }
        } else if ((ct >= 24 && ct < 33)) {
            bf16_t* dst = (bf16_t*)(ws + (ct < 32 ? WS_SQ : WS_SK)); const float* coss = (const float*)(ws + WS_COSS); const float* sins = (const float*)(ws + WS_SINS); const int ldc = ct < 32 ? 2048 : 256; const int colt = ct < 32 ? (ct - 24) * 256 : 0; const float sc = ct < 32 ? C2 : 1.0f; const int f0 = 16 * (wc & 1) + 4 * fq;
#pragma unroll
            for (int ai = 0; ai < 2; ++ai)
#pragma unroll
                for (int m = 0; m < 4; ++m) { const int row = row0 + ai * 128 + m * 16;
                    const f32x4 c = *(const f32x4*)(coss + (size_t)row * 32 + f0) * sc, s = *(const f32x4*)(sins + (size_t)row * 32 + f0) * sc;
#pragma unroll
                    for (int bj = 0; bj < 2; ++bj) { const f32x4 v0 = acc[ai][bj][m][0], v1 = acc[ai][bj][m][1]; const f32x4 o1 = v0 * c - v1 * s, o2 = v1 * c + v0 * s;
                        u32x4 w; w.x = cvt_pk(o1[0], o1[1]); w.y = cvt_pk(o1[2], o1[3]); w.z = cvt_pk(o2[0], o2[1]); w.w = cvt_pk(o2[2], o2[3]);
                        *(u32x4*)(dst + (size_t)row * ldc + colt + bj * 128 + cw) = w; } }
        } else if (ct >= 34) {
            const int colt = (ct - 34) * 256; bf16_t* gates = (bf16_t*)(ws + WS_GATES);
            f32x4 b0[2], b1[2];
#pragma unroll
            for (int bj = 0; bj < 2; ++bj) { b0[bj] = *(const f32x4*)(gate_bias + colt + bj * 128 + cw); b1[bj] = *(const f32x4*)(gate_bias + colt + bj * 128 + cw + 4); }
#pragma unroll
            for (int ai = 0; ai < 2; ++ai)
#pragma unroll
                for (int m = 0; m < 4; ++m) { const int row = row0 + ai * 128 + m * 16;
#pragma unroll
                    for (int bj = 0; bj < 2; ++bj) { const f32x4 v0 = acc[ai][bj][m][0] + b0[bj], v1 = acc[ai][bj][m][1] + b1[bj];
                        u32x4 w; w.x = cvt_pk(fast_sigmoid(v0[0]), fast_sigmoid(v0[1])); w.y = cvt_pk(fast_sigmoid(v0[2]), fast_sigmoid(v0[3]));
                        w.z = cvt_pk(fast_sigmoid(v1[0]), fast_sigmoid(v1[1])); w.w = cvt_pk(fast_sigmoid(v1[2]), fast_sigmoid(v1[3]));
                        *(u32x4*)(gates + (size_t)row * 4096 + colt + bj * 128 + cw) = w; } }
        } else {
            const bool act = (ct >= 16 && ct < 24);
            bf16_t* dst = (bf16_t*)(ws + (ct < 16 ? WS_RV : (ct < 24 ? WS_RG : WS_SV))); const int ldc = ct == 33 ? 256 : 2048; const int colt = ct < 16 ? (ct - 8) * 256 : (ct < 24 ? (ct - 16) * 256 : 0);
#pragma unroll
            for (int ai = 0; ai < 2; ++ai)
#pragma unroll
                for (int m = 0; m < 4; ++m) { const int row = row0 + ai * 128 + m * 16;
#pragma unroll
                    for (int bj = 0; bj < 2; ++bj) { f32x4 v0 = acc[ai][bj][m][0], v1 = acc[ai][bj][m][1];
                        if (act) {
#pragma unroll
                            for (int j = 0; j < 4; ++j) { v0[j] = v0[j] * fast_sigmoid(v0[j]); v1[j] = v1[j] * fast_sigmoid(v1[j]); } }
                        u32x4 w; w.x = cvt_pk(v0[0], v0[1]); w.y = cvt_pk(v0[2], v0[3]); w.z = cvt_pk(v1[0], v1[1]); w.w = cvt_pk(v1[2], v1[3]);
                        *(u32x4*)(dst + (size_t)row * ldc + colt + bj * 128 + cw) = w; } }
        }
    }
};
struct EpiMix {
    static constexpr bool PERM = true;
    const bf16_t* gates; bf16_t* mix;
    __device__ __forceinline__ void operator()(const f32x4 (&acc)[2][2][4][2], const Unit& u, int wr, int wc, int fr, int fq) const {
        const int br = u.pm >> 6, pm = u.pm & 63, ct = u.pn & 7; const int row0 = pm * 256 + wr * 64 + fr; const int col0 = ct * 256 + wc * 32 + 8 * fq;
#pragma unroll
        for (int ai = 0; ai < 2; ++ai)
#pragma unroll
            for (int m = 0; m < 4; ++m) { const int row = row0 + ai * 128 + m * 16;
#pragma unroll
                for (int bj = 0; bj < 2; ++bj) { const int col = col0 + bj * 128;
                    const u32x4 g = *(const u32x4*)(gates + (size_t)row * 4096 + br * 2048 + col);
                    f32x4 v0 = acc[ai][bj][m][0], v1 = acc[ai][bj][m][1];
                    v0[0] *= bf_lo(g.x); v0[1] *= bf_hi(g.x); v0[2] *= bf_lo(g.y); v0[3] *= bf_hi(g.y); v1[0] *= bf_lo(g.z); v1[1] *= bf_hi(g.z); v1[2] *= bf_lo(g.w); v1[3] *= bf_hi(g.w);
                    bf16_t* dp = mix + (size_t)row * 2048 + col;
                    if (br) { const u32x4 t = *(const u32x4*)dp;
                        v0[0] += bf_lo(t.x); v0[1] += bf_hi(t.x); v0[2] += bf_lo(t.y); v0[3] += bf_hi(t.y); v1[0] += bf_lo(t.z); v1[1] += bf_hi(t.z); v1[2] += bf_lo(t.w); v1[3] += bf_hi(t.w); }
                    u32x4 w; w.x = cvt_pk(v0[0], v0[1]); w.y = cvt_pk(v0[2], v0[3]); w.z = cvt_pk(v1[0], v1[1]); w.w = cvt_pk(v1[2], v1[3]);
                    *(u32x4*)dp = w; } }
    }
};
struct EpiResid {
    static constexpr bool PERM = false;
    const float* x; float* h2;
    __device__ __forceinline__ void operator()(const f32x4 (&acc)[2][2][4][2], const Unit& u, int wr, int wc, int fr, int fq) const {
        const int row0 = u.pm * 256 + wr * 64 + fr, col0 = u.pn * 256 + wc * 32 + 4 * fq;
#pragma unroll
        for (int ai = 0; ai < 2; ++ai)
#pragma unroll
            for (int m = 0; m < 4; ++m) { const size_t off = (size_t)(row0 + ai * 128 + m * 16) * 2048 + col0;
#pragma unroll
                for (int bj = 0; bj < 2; ++bj)
#pragma unroll
                    for (int n = 0; n < 2; ++n) { const f32x4 xv = *(const f32x4*)(x + off + bj * 128 + n * 16); *(f32x4*)(h2 + off + bj * 128 + n * 16) = xv + acc[ai][bj][m][n]; } }
    }
};
struct EpiSwiglu {
    static constexpr bool PERM = true;
    const float* b_gate_up; bf16_t* act;
    __device__ __forceinline__ void operator()(const f32x4 (&acc)[2][2][4][2], const Unit& u, int wr, int wc, int fr, int fq) const {
        const int e = u.pn >> 4, ct = u.pn & 15; const int row0 = u.pm * 256 + wr * 64 + fr; const int col0 = ct * 256 + wc * 32 + 8 * fq;
        f32x4 b0[2], b1[2];
#pragma unroll
        for (int bj = 0; bj < 2; ++bj) { b0[bj] = *(const f32x4*)(b_gate_up + (size_t)e * 4096 + col0 + bj * 128); b1[bj] = *(const f32x4*)(b_gate_up + (size_t)e * 4096 + col0 + bj * 128 + 4); }
#pragma unroll
        for (int ai = 0; ai < 2; ++ai)
#pragma unroll
            for (int m = 0; m < 4; ++m) { const int row = row0 + ai * 128 + m * 16;
#pragma unroll
                for (int bj = 0; bj < 2; ++bj) { const f32x4 v0 = acc[ai][bj][m][0] + b0[bj], v1 = acc[ai][bj][m][1] + b1[bj];
                    float a[4];
#pragma unroll
                    for (int j = 0; j < 4; ++j) { const float gt = fminf(j < 2 ? v0[2 * j] : v1[2 * j - 4], 7.0f); const float ln = fminf(fmaxf(j < 2 ? v0[2 * j + 1] : v1[2 * j - 3], -7.0f), 7.0f);
                        a[j] = gt * fast_sigmoid(1.702f * gt) * (ln + 1.0f); }
                    u32x2 w; w.x = cvt_pk(a[0], a[1]); w.y = cvt_pk(a[2], a[3]);
                    *(u32x2*)(act + (size_t)row * 2048 + ((col0 + bj * 128) >> 1)) = w; } }
    }
};
struct EpiDown {
    static constexpr bool PERM = true;
    const float* b_down; bf16_t* y;
    __device__ __forceinline__ void operator()(const f32x4 (&acc)[2][2][4][2], const Unit& u, int wr, int wc, int fr, int fq) const {
        const int e = u.pn >> 3, ct = u.pn & 7; const int row0 = u.pm * 256 + wr * 64 + fr; const int col0 = ct * 256 + wc * 32 + 8 * fq;
        f32x4 b0[2], b1[2];
#pragma unroll
        for (int bj = 0; bj < 2; ++bj) { b0[bj] = *(const f32x4*)(b_down + (size_t)e * 2048 + col0 + bj * 128); b1[bj] = *(const f32x4*)(b_down + (size_t)e * 2048 + col0 + bj * 128 + 4); }
#pragma unroll
        for (int ai = 0; ai < 2; ++ai)
#pragma unroll
            for (int m = 0; m < 4; ++m) { const int row = row0 + ai * 128 + m * 16;
#pragma unroll
                for (int bj = 0; bj < 2; ++bj) { const f32x4 v0 = acc[ai][bj][m][0] + b0[bj], v1 = acc[ai][bj][m][1] + b1[bj];
                    u32x4 w; w.x = cvt_pk(v0[0], v0[1]); w.y = cvt_pk(v0[2], v0[3]); w.z = cvt_pk(v1[0], v1[1]); w.w = cvt_pk(v1[2], v1[3]);
                    *(u32x4*)(y + (size_t)row * 2048 + col0 + bj * 128) = w; } }
    }
};

__device__ __forceinline__ float wave_sum(float v) {
#pragma unroll
    for (int o = 1; o < 64; o <<= 1) v += __shfl_xor(v, o);
    return v;
}
__device__ __forceinline__ int win_src_col4(int n) {
    if (n < 2048) { const int p = n & 127; return (n & ~127) + ((p >> 2) & 1) * 64 + 4 * (p >> 3); }
    if (n >= 6144 && n < 8448) { const int p = n & 63; return (n & ~63) + ((p >> 2) & 1) * 32 + 4 * (p >> 3); }
    return n;
}
__device__ __forceinline__ void p0_transpose_tile(const float* W, int N, bf16_t* WT, int K, int k0, int n0, int srccol, LAS float* scr, int lane) {
    f32x4 v[16];
#pragma unroll
    for (int i = 0; i < 16; ++i) v[i] = *(const f32x4*)(W + (size_t)(k0 + (lane >> 4) + 4 * i) * N + srccol);
#pragma unroll
    for (int i = 0; i < 16; ++i) { LAS float* d = scr + ((lane >> 4) + 4 * i) * 65 + 4 * (lane & 15); d[0] = v[i][0]; d[1] = v[i][1]; d[2] = v[i][2]; d[3] = v[i][3]; }
    asm volatile("s_waitcnt lgkmcnt(0)" ::: "memory");
    const int c = lane & 7;
#pragma unroll
    for (int j = 0; j < 8; ++j) { const int n = (lane >> 3) + 8 * j; const LAS float* s = scr + (8 * c) * 65 + n;
        u32x4 o; o.x = cvt_pk(s[0], s[65]); o.y = cvt_pk(s[2 * 65], s[3 * 65]); o.z = cvt_pk(s[4 * 65], s[5 * 65]); o.w = cvt_pk(s[6 * 65], s[7 * 65]);
        *(u32x4*)(WT + (size_t)(n0 + n) * K + k0 + 8 * c) = o; }
    asm volatile("s_waitcnt lgkmcnt(0)" ::: "memory");
}
__device__ __forceinline__ void p0_prologue(const Params& p, LAS unsigned char* lds, int vcu, int G) {
    const int tid = threadIdx.x, lane = tid & 63, wave = __builtin_amdgcn_readfirstlane(tid >> 6);
    LAS float* scr = (LAS float*)(lds + wave * 16640);
    const int gw = vcu * 8 + wave, NGW = G * 8;
    unsigned char* ws = p.ws;
    constexpr int T_IN = 32 * 200, T_SQ = 32 * 32, T_GU = 32 * 32 * 64, T_DN = 32 * 32 * 32;
    constexpr int NT_ALL = T_IN + 3 * T_SQ + T_GU + T_DN;
    for (int it = gw; it < NT_ALL; it += NGW) {
        int r = it;
        if (r < T_IN) { const int kb = r / 200, nb = r % 200; const int n0 = nb * 64; p0_transpose_tile(p.w_in, INW, (bf16_t*)(ws + WS_WIN_T), DM, kb * 64, n0, win_src_col4(n0 + 4 * (lane & 15)), scr, lane); continue; } r -= T_IN;
        if (r < 3 * T_SQ) { const int w = r / T_SQ; r -= w * T_SQ; const int kb = r / 32, nb = r % 32; const float* W = w == 0 ? p.w_ret_out : (w == 1 ? p.w_swa_out : p.w_o);
            bf16_t* WT = w == 2 ? (bf16_t*)(ws + WS_WO_T) : (bf16_t*)(ws + WS_WBR_T) + (size_t)w * DM * DM;
            p0_transpose_tile(W, DM, WT, DM, kb * 64, nb * 64, nb * 64 + 4 * (lane & 15), scr, lane); continue; } r -= 3 * T_SQ;
        if (r < T_GU) { const int e = r / 2048; r -= e * 2048; const int kb = r / 64, nb = r % 64;
            p0_transpose_tile(p.w_gate_up + (size_t)e * DM * 4096, 4096, (bf16_t*)(ws + WS_WGU_T) + (size_t)e * 4096 * DM, DM, kb * 64, nb * 64, nb * 64 + 4 * (lane & 15), scr, lane); continue; } r -= T_GU;
        { const int e = r / 1024; r -= e * 1024; const int kb = r / 32, nb = r % 32;
            p0_transpose_tile(p.w_down + (size_t)e * DFF * DM, DM, (bf16_t*)(ws + WS_WDN_T) + (size_t)e * DM * DFF, DFF, kb * 64, nb * 64, nb * 64 + 4 * (lane & 15), scr, lane); }
    }
    for (int m = gw; m < NTOK; m += NGW) {
        const f32x4* xr = (const f32x4*)(p.x + (size_t)m * DM) + lane; const f32x4* wr = (const f32x4*)p.attn_norm_w + lane;
        f32x4 v[8]; float s = 0.f;
#pragma unroll
        for (int j = 0; j < 8; ++j) { v[j] = xr[64 * j]; s += (v[j][0] * v[j][0] + v[j][1] * v[j][1]) + (v[j][2] * v[j][2] + v[j][3] * v[j][3]); }
        const float rs = rsqrtf(wave_sum(s) * (1.0f / DM) + RMS_EPS);
        u32x2* o8 = (u32x2*)((bf16_t*)(ws + WS_XN) + (size_t)m * DM) + lane;
#pragma unroll
        for (int j = 0; j < 8; ++j) { const f32x4 w = wr[64 * j]; u32x2 o; o.x = cvt_pk(v[j][0] * rs * w[0], v[j][1] * rs * w[1]); o.y = cvt_pk(v[j][2] * rs * w[2], v[j][3] * rs * w[3]); o8[64 * j] = o; }
    }
    const int gt = (vcu * 512 + tid), NGT = G * 512;
    for (int i = gt; i < NTOK * 96; i += NGT) {
        const int tok = i / 96, f = i % 96; const float pos = (float)p.positions[tok];
        float inv; if (f < 64) inv = expf(-9.210340371976184f * (float)(2 * f) * (1.0f / 128.0f)); else inv = expf(-9.210340371976184f * (float)(2 * (f - 64)) * (1.0f / 64.0f));
        const float ang = pos * inv; float sn, cs; sincosf(ang, &sn, &cs);
        if (f < 64) { ((float*)(ws + WS_COSR))[(size_t)tok * 64 + f] = cs; ((float*)(ws + WS_SINR))[(size_t)tok * 64 + f] = sn; }
        else { ((float*)(ws + WS_COSS))[(size_t)tok * 32 + f - 64] = cs; ((float*)(ws + WS_SINS))[(size_t)tok * 32 + f - 64] = sn; }
    }
}

__device__ __forceinline__ float ret_l2g(int h) { return log1pf(-exp2f(-5.0f - (float)h)) * LOG2E; }

__device__ __forceinline__ void ret_u_unit(LAS unsigned char* lds, const bf16_t* RK, const bf16_t* RV, float* UT, int b, int n, int h) {
    int tid_ = threadIdx.x; asm volatile("" : "+v"(tid_));
    const int tid = tid_, lane = tid & 63, r32 = lane & 31, hi = lane >> 5; const int wid = __builtin_amdgcn_readfirstlane(tid >> 6);
    const size_t tok0 = (size_t)b * SEQ + (size_t)n * 128;
    const float l2g = ret_l2g(h);
#pragma unroll
    for (int i = 0; i < 4; ++i) { const int x = tid + 512 * i, ch = x & 15, row = x >> 4;
        const u32x4 v = *(const u32x4*)(RK + (tok0 + row) * 1024 + h * 128 + ch * 8);
        *(LAS u32x4*)(lds + (ch >> 2) * 8192 + row * 64 + (ch & 3) * 16) = v; }
#pragma unroll
    for (int i = 0; i < 8; ++i) { const int x = tid + 512 * i, ch = x & 31, row = x >> 5;
        u32x4 v = *(const u32x4*)(RV + (tok0 + row) * 2048 + h * 256 + ch * 8);
        const float z = exp2f(l2g * (float)(127 - row));
        v.x = cvt_pk(bf_lo(v.x) * z, bf_hi(v.x) * z); v.y = cvt_pk(bf_lo(v.y) * z, bf_hi(v.y) * z); v.z = cvt_pk(bf_lo(v.z) * z, bf_hi(v.z) * z); v.w = cvt_pk(bf_lo(v.w) * z, bf_hi(v.w) * z);
        *(LAS u32x4*)(lds + 32768 + (ch >> 2) * 8192 + row * 64 + (ch & 3) * 16) = v; }
    __syncthreads();
    const int trb = (8 * hi + ((lane & 15) >> 2)) * 64 + ((lane >> 4) & 1) * 32 + (lane & 3) * 8;
    f32x16 acc[4];
#pragma unroll
    for (int c = 0; c < 4; ++c) acc[c] = (f32x16){};
#pragma unroll 2
    for (int ks = 0; ks < 8; ++ks) {
        const LAS unsigned char* ap = lds + 32768 + wid * 8192 + ks * 1024 + trb;
        const bf16x8 af = mk8(tr16(ap), tr16(ap + 256));
#pragma unroll
        for (int c = 0; c < 4; ++c) { const LAS unsigned char* bp = lds + c * 8192 + ks * 1024 + trb; const bf16x8 bfr = mk8(tr16(bp), tr16(bp + 256));
            acc[c] = __builtin_amdgcn_mfma_f32_32x32x16_bf16(af, bfr, acc[c], 0, 0, 0); }
    }
    float* up = UT + ((((size_t)b * 32 + n) * 8 + h) * 256 + 32 * wid) * 128;
#pragma unroll
    for (int c = 0; c < 4; ++c)
#pragma unroll
        for (int r = 0; r < 16; ++r) up[(size_t)crow(r, hi) * 128 + 32 * c + r32] = acc[c][r];
    __syncthreads();
}

__device__ __forceinline__ void swa_unit(LAS unsigned char* lds, const bf16_t* SQ, const bf16_t* SK, const bf16_t* SV, const float* sinks, bf16_t* SWAO, int b, int kvh, int n) {
    int tid_ = threadIdx.x; asm volatile("" : "+v"(tid_));
    const int tid = tid_, lane = tid & 63, r32 = lane & 31, hi = lane >> 5; const int wid = __builtin_amdgcn_readfirstlane(tid >> 6);
    const long tokq = (long)b * SEQ + (long)n * 128; const long band0 = tokq - 128;
#pragma unroll
    for (int i = 0; i < 4; ++i) { const int x = tid + 512 * i, ch = x & 7, row = x >> 3; long tk = band0 + row; if (tk < 0) tk = 0;
        const u32x4 kv = *(const u32x4*)(SK + tk * 256 + kvh * 64 + ch * 8); const u32x4 vv = *(const u32x4*)(SV + tk * 256 + kvh * 64 + ch * 8);
        *(LAS u32x4*)(lds + ch * 4096 + row * 16) = kv;
        *(LAS u32x4*)(lds + 32768 + (ch >> 2) * 16384 + row * 64 + (ch & 3) * 16) = vv; }
    __syncthreads();
    const int qh = kvh * 8 + wid; const float sink2 = sinks[qh] * LOG2E;
    const int trb = (4 * hi + ((lane & 15) >> 2)) * 64 + ((lane >> 4) & 1) * 32 + (lane & 3) * 8;
    for (int s = 0; s < 4; ++s) {
        bf16x8 qr[4];
#pragma unroll
        for (int d0 = 0; d0 < 4; ++d0) qr[d0] = *(const bf16x8*)(SQ + (size_t)(tokq + 32 * s + r32) * 2048 + qh * 64 + 16 * d0 + 8 * hi);
        const int t_lo = s < 2 ? 0 : 1;
        f32x16 pt[3][2];
#pragma unroll
        for (int tt = 0; tt < 3; ++tt)
#pragma unroll
            for (int hf = 0; hf < 2; ++hf) { f32x16 a = (f32x16){};
                const LAS unsigned char* kp = lds + hi * 4096 + (64 * (t_lo + tt) + 32 * hf + r32) * 16;
#pragma unroll
                for (int d0 = 0; d0 < 4; ++d0) { const bf16x8 kf = *(const LAS bf16x8*)(kp + d0 * 8192); a = __builtin_amdgcn_mfma_f32_32x32x16_bf16(kf, qr[d0], a, 0, 0, 0); }
                pt[tt][hf] = a; }
        const int iq = 32 * s + r32; float mx = sink2;
#pragma unroll
        for (int tt = 0; tt < 3; ++tt)
#pragma unroll
            for (int hf = 0; hf < 2; ++hf)
#pragma unroll
                for (int r = 0; r < 16; ++r) { const int jp = 64 * (t_lo + tt) + 32 * hf + crow(r, hi);
                    const bool valid = (jp > iq) && (jp <= iq + 128) && (n > 0 || jp >= 128);
                    const float v = valid ? pt[tt][hf][r] : -INFINITY; pt[tt][hf][r] = v; mx = fmaxf(mx, v); }
        mx = fmaxf(mx, __shfl_xor(mx, 32));
        float l = 0.f;
#pragma unroll
        for (int tt = 0; tt < 3; ++tt)
#pragma unroll
            for (int hf = 0; hf < 2; ++hf)
#pragma unroll
                for (int r = 0; r < 16; ++r) { const float e = exp2f(pt[tt][hf][r] - mx); pt[tt][hf][r] = e; l += e; }
        l += __shfl_xor(l, 32); l += exp2f(sink2 - mx);
        const float linv = 1.0f / l;
        f32x16 o[2]; o[0] = (f32x16){}; o[1] = (f32x16){};
#pragma unroll
        for (int tt = 0; tt < 3; ++tt)
#pragma unroll
            for (int hf = 0; hf < 2; ++hf)
#pragma unroll
                for (int k2 = 0; k2 < 2; ++k2) {
                    u32x4 pw; pw.x = cvt_pk(pt[tt][hf][8 * k2 + 0], pt[tt][hf][8 * k2 + 1]); pw.y = cvt_pk(pt[tt][hf][8 * k2 + 2], pt[tt][hf][8 * k2 + 3]);
                    pw.z = cvt_pk(pt[tt][hf][8 * k2 + 4], pt[tt][hf][8 * k2 + 5]); pw.w = cvt_pk(pt[tt][hf][8 * k2 + 6], pt[tt][hf][8 * k2 + 7]);
                    const bf16x8 pa = __builtin_bit_cast(bf16x8, pw);
                    const int krow = 64 * (t_lo + tt) + 32 * hf + 16 * k2;
#pragma unroll
                    for (int d0 = 0; d0 < 2; ++d0) { const LAS unsigned char* vp = lds + 32768 + d0 * 16384 + krow * 64 + trb; const bf16x8 vf = mk8(tr16(vp), tr16(vp + 512));
                        o[d0] = __builtin_amdgcn_mfma_f32_32x32x16_bf16(pa, vf, o[d0], 0, 0, 0); }
                }
        bf16_t* op = SWAO + (size_t)(tokq + 32 * s) * 2048 + qh * 64 + r32;
#pragma unroll
        for (int r = 0; r < 16; ++r) { const int q = crow(r, hi); const float li = __shfl(linv, q);
            op[(size_t)q * 2048] = (bf16_t)(cvt_pk(o[0][r] * li, 0.f) & 0xffffu); op[(size_t)q * 2048 + 32] = (bf16_t)(cvt_pk(o[1][r] * li, 0.f) & 0xffffu); }
    }
    __syncthreads();
}

__device__ __forceinline__ void ret_scan(const float* UT, bf16_t* PNT, int vcu, int G) {
    const int gt = vcu * 512 + threadIdx.x, NGT = G * 512;
    for (int idx = gt; idx < NB * 8 * 256 * 32; idx += NGT) {
        const int d4 = idx & 31, e = (idx >> 5) & 255, h = (idx >> 13) & 7, b = idx >> 16;
        const float dec = exp2f(ret_l2g(h) * 128.0f);
        f32x4 P = (f32x4){0.f, 0.f, 0.f, 0.f};
#pragma unroll 8
        for (int n = 0; n < 32; ++n) { const size_t off = ((((size_t)b * 32 + n) * 8 + h) * 256 + e) * 128 + 4 * d4;
            u32x2 o; o.x = cvt_pk(P[0], P[1]); o.y = cvt_pk(P[2], P[3]); *(u32x2*)(PNT + off) = o;
            if (n < 31) { const f32x4 U = *(const f32x4*)(UT + off); P = P * dec + U; } }
    }
}

__device__ __forceinline__ void ret_out_unit(LAS unsigned char* lds, const bf16_t* RQ, const bf16_t* RK, const bf16_t* RV, const bf16_t* RG, const bf16_t* PNT, bf16_t* RETO, int b, int n, int h) {
    int tid_ = threadIdx.x; asm volatile("" : "+v"(tid_));
    const int tid = tid_, lane = tid & 63, r32 = lane & 31, hi = lane >> 5; const int wid = __builtin_amdgcn_readfirstlane(tid >> 6);
    const size_t tok0 = (size_t)b * SEQ + (size_t)n * 128;
    const float l2g = ret_l2g(h);
#pragma unroll
    for (int i = 0; i < 4; ++i) { const int x = tid + 512 * i, ch = x & 15, row = x >> 4;
        const u32x4 v = *(const u32x4*)(RK + (tok0 + row) * 1024 + h * 128 + ch * 8);
        *(LAS u32x4*)(lds + ch * 2048 + row * 16) = v; }
#pragma unroll
    for (int i = 0; i < 8; ++i) { const int x = tid + 512 * i, ch = x & 31, row = x >> 5;
        const u32x4 v = *(const u32x4*)(RV + (tok0 + row) * 2048 + h * 256 + ch * 8);
        *(LAS u32x4*)(lds + 32768 + (ch >> 2) * 8192 + row * 64 + (ch & 3) * 16) = v; }
    __syncthreads();
    const int rb = wid & 3, eh = wid >> 2;
    bf16x8 qr[8];
#pragma unroll
    for (int d0 = 0; d0 < 8; ++d0) qr[d0] = *(const bf16x8*)(RQ + (tok0 + 32 * rb + r32) * 1024 + h * 128 + 16 * d0 + 8 * hi);
    f32x16 o[4];
#pragma unroll
    for (int c = 0; c < 4; ++c) o[c] = (f32x16){};
    if (n > 0) {
        const bf16_t* pp = PNT + ((((size_t)b * 32 + n) * 8 + h) * 256 + 128 * eh + r32) * 128 + 8 * hi;
#pragma unroll
        for (int d0 = 0; d0 < 8; ++d0) {
#pragma unroll
            for (int c = 0; c < 4; ++c) { const bf16x8 bfr = *(const bf16x8*)(pp + (size_t)(32 * c) * 128 + 16 * d0); o[c] = __builtin_amdgcn_mfma_f32_32x32x16_bf16(qr[d0], bfr, o[c], 0, 0, 0); }
            if (d0 & 1) asm volatile("" ::: "memory"); }
#pragma unroll
        for (int r = 0; r < 16; ++r) { const float xi = exp2f(l2g * (float)(32 * rb + crow(r, hi) + 1));
#pragma unroll
            for (int c = 0; c < 4; ++c) o[c][r] *= xi; }
    }
    const int trb = (4 * hi + ((lane & 15) >> 2)) * 64 + ((lane >> 4) & 1) * 32 + (lane & 3) * 8;
    for (int jb = 0; jb <= rb; ++jb) {
        f32x16 st = (f32x16){};
        const LAS unsigned char* kp = lds + hi * 2048 + (32 * jb + r32) * 16;
#pragma unroll
        for (int d0 = 0; d0 < 8; ++d0) { const bf16x8 kf = *(const LAS bf16x8*)(kp + d0 * 4096); st = __builtin_amdgcn_mfma_f32_32x32x16_bf16(kf, qr[d0], st, 0, 0, 0); }
        const int iq = 32 * rb + r32;
#pragma unroll
        for (int r = 0; r < 16; ++r) { const int j = 32 * jb + crow(r, hi); const int dd = iq - j; st[r] = dd >= 0 ? st[r] * exp2f(l2g * (float)dd) : 0.f; }
#pragma unroll
        for (int k2 = 0; k2 < 2; ++k2) {
            u32x4 pw; pw.x = cvt_pk(st[8 * k2 + 0], st[8 * k2 + 1]); pw.y = cvt_pk(st[8 * k2 + 2], st[8 * k2 + 3]); pw.z = cvt_pk(st[8 * k2 + 4], st[8 * k2 + 5]); pw.w = cvt_pk(st[8 * k2 + 6], st[8 * k2 + 7]);
            const bf16x8 pa = __builtin_bit_cast(bf16x8, pw);
            const int krow = 32 * jb + 16 * k2;
#pragma unroll
            for (int c = 0; c < 4; ++c) { const LAS unsigned char* vp = lds + 32768 + (4 * eh + c) * 8192 + krow * 64 + trb; const bf16x8 vf = mk8(tr16(vp), tr16(vp + 512));
                o[c] = __builtin_amdgcn_mfma_f32_32x32x16_bf16(pa, vf, o[c], 0, 0, 0); }
        }
    }
    float ss[16];
#pragma unroll
    for (int r = 0; r < 16; ++r) { float a = 0.f;
#pragma unroll
        for (int c = 0; c < 4; ++c) a += o[c][r] * o[c][r];
        a += __shfl_xor(a, 1); a += __shfl_xor(a, 2); a += __shfl_xor(a, 4); a += __shfl_xor(a, 8); a += __shfl_xor(a, 16); ss[r] = a; }
    __syncthreads();
    LAS float* sx = (LAS float*)(lds + 98304);
    if (r32 == 0) {
#pragma unroll
        for (int r = 0; r < 16; ++r) sx[wid * 32 + crow(r, hi)] = ss[r]; }
    __syncthreads();
    const bf16_t* gp = RG + (tok0 + 32 * rb) * 2048 + h * 256 + 128 * eh + r32;
    bf16_t* op = RETO + (tok0 + 32 * rb) * 2048 + h * 256 + 128 * eh + r32;
#pragma unroll
    for (int r = 0; r < 16; ++r) { const int q = crow(r, hi); const float tot = ss[r] + sx[(wid ^ 4) * 32 + q]; const float rstd = rsqrtf(tot * (1.0f / 256.0f) + RMS_EPS);
#pragma unroll
        for (int c = 0; c < 4; ++c) { const float g = __uint_as_float((unsigned)gp[(size_t)q * 2048 + 32 * c] << 16);
            op[(size_t)q * 2048 + 32 * c] = (bf16_t)(cvt_pk(o[c][r] * rstd * g, 0.f) & 0xffffu); } }
    __syncthreads();
}

__device__ __forceinline__ void p5_router(const Params& p, LAS unsigned char* lds, int blk) {
    int tid_ = threadIdx.x; asm volatile("" : "+v"(tid_));
    const int tid = tid_, lane = tid & 63, r32 = lane & 31, hi = lane >> 5; const int wid = __builtin_amdgcn_readfirstlane(tid >> 6);
    unsigned char* ws = p.ws; const float* H2 = (const float*)(ws + WS_H2);
    const int tok0 = blk * 64;
    LAS float* hc = (LAS float*)lds;
    LAS float* wc = (LAS float*)(lds + 65792);
    LAS float* ssr = (LAS float*)(lds + 98560);
    LAS int* cntl = (LAS int*)(lds + 98816);
    LAS int* gb = (LAS int*)(lds + 98944);
    LAS float* pl = (LAS float*)lds;
    if (tid < 32) cntl[tid] = 0;
    const int mt = wid & 1, ksub = wid >> 1;
    const int lrow = tid >> 3, lc0 = (tid & 7) * 32;
    f32x16 acc = (f32x16){}; float ssq = 0.f;
    for (int kc = 0; kc < 8; ++kc) {
#pragma unroll
        for (int j = 0; j < 8; ++j) { const f32x4 hv = *(const f32x4*)(H2 + (size_t)(tok0 + lrow) * DM + kc * 256 + lc0 + 4 * j); const f32x4 wv = *(const f32x4*)(p.ffn_norm_w + kc * 256 + lc0 + 4 * j);
            const f32x4 t = hv * wv; ssq += (hv[0] * hv[0] + hv[1] * hv[1]) + (hv[2] * hv[2] + hv[3] * hv[3]);
            LAS float* d = hc + lrow * 257 + lc0 + 4 * j; d[0] = t[0]; d[1] = t[1]; d[2] = t[2]; d[3] = t[3]; }
#pragma unroll
        for (int i = 0; i < 4; ++i) { const int x = tid + 512 * i, k = x >> 3, e4 = x & 7; *(LAS f32x4*)(wc + k * 32 + 4 * e4) = *(const f32x4*)(p.router_w + (size_t)(kc * 256 + k) * 32 + 4 * e4); }
        __syncthreads();
#pragma unroll 8
        for (int kk = 0; kk < 32; ++kk) { const int k0 = 64 * ksub + 2 * kk + hi; const float a = hc[(32 * mt + r32) * 257 + k0]; const float bb = wc[k0 * 32 + r32];
            acc = __builtin_amdgcn_mfma_f32_32x32x2f32(a, bb, acc, 0, 0, 0); }
        __syncthreads();
    }
    ssq += __shfl_xor(ssq, 1); ssq += __shfl_xor(ssq, 2); ssq += __shfl_xor(ssq, 4);
    if ((tid & 7) == 0) ssr[lrow] = ssq;
#pragma unroll
    for (int r = 0; r < 16; ++r) pl[wid * 1056 + crow(r, hi) * 33 + r32] = acc[r];
    __syncthreads();
    int te[4]; int lr[4]; float tw[4];
    if (tid < 64) {
        const int mt2 = tid >> 5, row = tid & 31; const float rs = rsqrtf(ssr[tid] * (1.0f / DM) + RMS_EPS);
        float v[32];
#pragma unroll
        for (int e = 0; e < 32; ++e) { float a = 0.f;
#pragma unroll
            for (int ks = 0; ks < 4; ++ks) a += pl[(mt2 + 2 * ks) * 1056 + row * 33 + e];
            v[e] = a * rs + p.router_b[e]; }
        float tv[4];
#pragma unroll
        for (int k = 0; k < 4; ++k) { float best = -INFINITY; int bi = 0;
#pragma unroll
            for (int e = 0; e < 32; ++e) if (v[e] > best) { best = v[e]; bi = e; }
#pragma unroll
            for (int e = 0; e < 32; ++e) if (e == bi) v[e] = -INFINITY;
            tv[k] = best; te[k] = bi; }
        float sum = 0.f;
#pragma unroll
        for (int k = 0; k < 4; ++k) { tw[k] = __expf(tv[k] - tv[0]); sum += tw[k]; }
        const float inv = 1.0f / sum;
#pragma unroll
        for (int k = 0; k < 4; ++k) { tw[k] *= inv; lr[k] = atomicAdd((int*)&cntl[te[k]], 1); }
    }
    __syncthreads();
    if (tid < 32) { const int c = cntl[tid]; int base = 0; if (c > 0) base = (int)atomicAdd((unsigned*)(ws + WS_CTL) + CW_CNT + tid, (unsigned)c); gb[tid] = base; }
    __syncthreads();
    if (tid < 64) { const int tok = tok0 + tid;
#pragma unroll
        for (int k = 0; k < 4; ++k) { const int rank = gb[te[k]] + lr[k];
            ((int*)(ws + WS_LIST))[(size_t)te[k] * NTOK + rank] = tok; ((int*)(ws + WS_TOKE))[tok * 4 + k] = te[k]; ((int*)(ws + WS_TOKR))[tok * 4 + k] = rank; ((float*)(ws + WS_TOKW))[tok * 4 + k] = tw[k]; } }
    for (int rr = 0; rr < 8; ++rr) { const int row = wid * 8 + rr; const float rs = rsqrtf(ssr[row] * (1.0f / DM) + RMS_EPS);
        const f32x4* hr = (const f32x4*)(H2 + (size_t)(tok0 + row) * DM) + lane; const f32x4* wr = (const f32x4*)p.ffn_norm_w + lane; u32x2* o8 = (u32x2*)((bf16_t*)(ws + WS_A2N) + (size_t)(tok0 + row) * DM) + lane;
#pragma unroll
        for (int j = 0; j < 8; ++j) { const f32x4 hv = hr[64 * j], wv = wr[64 * j]; u32x2 o; o.x = cvt_pk(hv[0] * rs * wv[0], hv[1] * rs * wv[1]); o.y = cvt_pk(hv[2] * rs * wv[2], hv[3] * rs * wv[3]); o8[64 * j] = o; } }
    __syncthreads();
}

__device__ __forceinline__ int moe_tables(const Params& p, LAS unsigned char* lds) {
    LAS int* cnt = (LAS int*)(lds + MISC_OFF + 64); LAS int* tile0 = (LAS int*)(lds + MISC_OFF + 192); LAS int* mte = (LAS int*)(lds + MISC_OFF + 512);
    const int tid = threadIdx.x;
    if (tid < 32) cnt[tid] = (int)__hip_atomic_load((unsigned*)(p.ws + WS_CTL) + CW_CNT + tid, __ATOMIC_RELAXED, __HIP_MEMORY_SCOPE_AGENT);
    __syncthreads();
    if (tid == 0) { int t = 0; for (int e = 0; e < 32; ++e) { tile0[e] = t; const int nt = (cnt[e] + 255) >> 8; for (int j = 0; j < nt && t + j < MAXT; ++j) mte[t + j] = e; t += nt; if (t > MAXT) t = MAXT; } tile0[32] = t; }
    __syncthreads();
    return __builtin_amdgcn_readfirstlane(tile0[32]);
}

__device__ __forceinline__ void p8_final(const Params& p, LAS unsigned char* lds, int vcu, int G) {
    const int tid = threadIdx.x, lane = tid & 63, wave = __builtin_amdgcn_readfirstlane(tid >> 6);
    unsigned char* ws = p.ws; const LAS int* tile0 = (const LAS int*)(lds + MISC_OFF + 192);
    const int gw = vcu * 8 + wave, NGW = G * 8;
    for (int m = gw; m < NTOK; m += NGW) {
        const f32x4* hr = (const f32x4*)((const float*)(ws + WS_H2) + (size_t)m * DM) + lane;
        f32x4 v[8];
#pragma unroll
        for (int j = 0; j < 8; ++j) v[j] = hr[64 * j];
#pragma unroll
        for (int k = 0; k < 4; ++k) { const int e = ((const int*)(ws + WS_TOKE))[m * 4 + k], rank = ((const int*)(ws + WS_TOKR))[m * 4 + k]; const float w = ((const float*)(ws + WS_TOKW))[m * 4 + k];
            const size_t slot = (size_t)tile0[e] * 256 + rank; const u32x2* yr = (const u32x2*)((const bf16_t*)(ws + WS_Y) + slot * DM) + lane;
#pragma unroll
            for (int j = 0; j < 8; ++j) { const u32x2 y = yr[64 * j]; v[j][0] += w * bf_lo(y.x); v[j][1] += w * bf_hi(y.x); v[j][2] += w * bf_lo(y.y); v[j][3] += w * bf_hi(y.y); } }
        float s = 0.f;
#pragma unroll
        for (int j = 0; j < 8; ++j) s += (v[j][0] * v[j][0] + v[j][1] * v[j][1]) + (v[j][2] * v[j][2] + v[j][3] * v[j][3]);
        const float rs = rsqrtf(wave_sum(s) * (1.0f / DM) + RMS_EPS);
        const f32x4* wr = (const f32x4*)p.final_norm_w + lane; f32x4* orow = (f32x4*)(p.out + (size_t)m * DM) + lane;
#pragma unroll
        for (int j = 0; j < 8; ++j) orow[64 * j] = v[j] * rs * wr[64 * j];
    }
}

constexpr int NPHASE = 11;
__global__ void __launch_bounds__(512, 2) fwd(Params p) {
    extern __shared__ __attribute__((aligned(16))) unsigned char lds_raw[];
    LAS unsigned char* lds = (LAS unsigned char*)lds_raw;
    const int tid = threadIdx.x;
    const int G = gridDim.x; const int bx = blockIdx.x; const int vcu = (G % 8 == 0) ? (bx % 8) * (G / 8) + bx / 8 : bx;
    unsigned char* ws = p.ws;
    for (int u = tid; u < 1024; u += 512) ((LAS unsigned*)(lds + MISC_OFF))[u] = 0u;
    __syncthreads();
    XcdBarrier bar; bar.bar = (unsigned*)(ws + WS_CTL) + CW_BAR; bar.x = 0; bar.st = nullptr;
    const int lo = p.ph_lo, hi = p.ph_hi;
    if (hi - lo > 1) bar = xcd_barrier_post((unsigned*)(ws + WS_CTL) + CW_BAR, (volatile LAS unsigned*)(lds + MISC_OFF));
#ifndef PHASE_MASK
#define PHASE_MASK 0x7ff
#endif
#define IN(k) (((PHASE_MASK >> (k)) & 1) && lo <= (k) && (k) < hi)
#define SEAM(k) do { if (IN(k) && IN((k) + 1)) xcd_barrier(bar); } while (0)

    bf16_t* XN = (bf16_t*)(ws + WS_XN); bf16_t* RQ = (bf16_t*)(ws + WS_RQ); bf16_t* RK = (bf16_t*)(ws + WS_RK); bf16_t* RV = (bf16_t*)(ws + WS_RV); bf16_t* RG = (bf16_t*)(ws + WS_RG);
    bf16_t* SQ = (bf16_t*)(ws + WS_SQ); bf16_t* SK = (bf16_t*)(ws + WS_SK); bf16_t* SV = (bf16_t*)(ws + WS_SV); bf16_t* GATES = (bf16_t*)(ws + WS_GATES);
    bf16_t* BR = (bf16_t*)(ws + WS_BR); bf16_t* MIX = (bf16_t*)(ws + WS_MIX);

    if (IN(0)) { p0_prologue(p, lds, vcu, G); }
    SEAM(0);
    if (IN(1)) {
        StaticOrder S{64, 50, G, bx};
        EpiProj E{ws, p.gate_bias};
        pg8::gemm_phase<EpiProj, StaticOrder>(lds, XN, (const bf16_t*)(ws + WS_WIN_T), DM, S, E);
    }
    SEAM(1);
    if (IN(2)) {
        for (int it = vcu; it < NB * 31 * 8; it += G) { const int h = it & 7, n = (it >> 3) % 31, b = it / 248; ret_u_unit(lds, RK, RV, (float*)(ws + WS_UT), b, n, h); }
        for (int it = vcu; it < NB * 32 * 4; it += G) { const int kvh = it & 3, n = (it >> 2) & 31, b = it >> 7; swa_unit(lds, SQ, SK, SV, p.sinks, BR + (size_t)NTOK * DM, b, kvh, n); }
    }
    SEAM(2);
    if (IN(3)) { ret_scan((const float*)(ws + WS_UT), (bf16_t*)(ws + WS_PNT), vcu, G); }
    SEAM(3);
    if (IN(4)) {
        for (int it = vcu; it < NB * 32 * 8; it += G) { const int h = it & 7, n = (it >> 3) & 31, b = it >> 8; ret_out_unit(lds, RQ, RK, RV, RG, (const bf16_t*)(ws + WS_PNT), BR, b, n, h); }
    }
    SEAM(4);
    if (IN(5)) {
        MixOrder S{G, bx}; EpiMix E{GATES, MIX};
        pg8::gemm_phase<EpiMix, MixOrder>(lds, BR, (const bf16_t*)(ws + WS_WBR_T), DM, S, E);
    }
    SEAM(5);
    if (IN(6)) {
        StaticOrder S{64, 8, G, bx}; EpiResid E{p.x, (float*)(ws + WS_H2)};
        pg8::gemm_phase<EpiResid, StaticOrder>(lds, MIX, (const bf16_t*)(ws + WS_WO_T), DM, S, E);
    }
    SEAM(6);
    if (IN(7)) { for (int blk = vcu; blk < NTOK / 64; blk += G) p5_router(p, lds, blk); }
    SEAM(7);
    if (IN(8)) {
        const int T = moe_tables(p, lds);
        MoeOrder<true> S{T, 16, G, bx, (const LAS int*)(lds + MISC_OFF + 64), (const LAS int*)(lds + MISC_OFF + 192), (const LAS int*)(lds + MISC_OFF + 512), (const int*)(ws + WS_LIST)};
        EpiSwiglu E{p.b_gate_up, (bf16_t*)(ws + WS_ACT)};
        pg8::gemm_phase<EpiSwiglu, MoeOrder<true>>(lds, (const bf16_t*)(ws + WS_A2N), (const bf16_t*)(ws + WS_WGU_T), DM, S, E);
    }
    SEAM(8);
    if (IN(9)) {
        const int T = moe_tables(p, lds);
        MoeOrder<false> S{T, 8, G, bx, (const LAS int*)(lds + MISC_OFF + 64), (const LAS int*)(lds + MISC_OFF + 192), (const LAS int*)(lds + MISC_OFF + 512), (const int*)(ws + WS_LIST)};
        EpiDown E{p.b_down, (bf16_t*)(ws + WS_Y)};
        pg8::gemm_phase<EpiDown, MoeOrder<false>>(lds, (const bf16_t*)(ws + WS_ACT), (const bf16_t*)(ws + WS_WDN_T), DFF, S, E);
    }
    SEAM(9);
    if (IN(10)) { (void)moe_tables(p, lds); p8_final(p, lds, vcu, G); }
#undef IN
#undef SEAM
}

extern "C" void kernel_launch(void* const* d_in, const int* in_sizes, int n_in, void* d_out, int out_size, void* d_ws, size_t ws_size, hipStream_t stream) {
    static int grid = 0;
    if (grid == 0) {
        if (n_in != 17 || out_size != NTOK * DM || ws_size < WS_END) { fprintf(stderr, "kernel_launch: unexpected shapes (n_in %d, out %d, ws %zu, need %zu)\n", n_in, out_size, ws_size, (size_t)WS_END); grid = -1; return; }
        int dev = 0, cus = 0;
        if (hipGetDevice(&dev) != hipSuccess || hipDeviceGetAttribute(&cus, hipDeviceAttributeMultiprocessorCount, dev) != hipSuccess) { grid = -1; return; }
        if (hipFuncSetAttribute((const void*)fwd, hipFuncAttributeMaxDynamicSharedMemorySize, LDS_BYTES) != hipSuccess) { fprintf(stderr, "kernel_launch: hipFuncSetAttribute failed\n"); grid = -1; return; }
        int per_cu = 0;
        if (hipOccupancyMaxActiveBlocksPerMultiprocessor(&per_cu, (const void*)fwd, 512, LDS_BYTES) != hipSuccess || per_cu < 1) fprintf(stderr, "kernel_launch: occupancy query reports %d\n", per_cu);
        (void)hipGetLastError();
        grid = cus;
    }
    if (grid < 0) return;
    (void)hipMemsetAsync((char*)d_ws + WS_CTL, 0, CTL_BYTES, stream);
    Params p{};
    p.x = (const float*)d_in[0]; p.positions = (const int*)d_in[1]; p.attn_norm_w = (const float*)d_in[2]; p.w_in = (const float*)d_in[3]; p.gate_bias = (const float*)d_in[4];
    p.w_ret_out = (const float*)d_in[5]; p.w_swa_out = (const float*)d_in[6]; p.w_o = (const float*)d_in[7]; p.sinks = (const float*)d_in[8]; p.ffn_norm_w = (const float*)d_in[9];
    p.router_w = (const float*)d_in[10]; p.router_b = (const float*)d_in[11]; p.w_gate_up = (const float*)d_in[12]; p.b_gate_up = (const float*)d_in[13]; p.w_down = (const float*)d_in[14];
    p.b_down = (const float*)d_in[15]; p.final_norm_w = (const float*)d_in[16]; p.out = (float*)d_out; p.ws = (unsigned char*)d_ws;
#if MK_N_LAUNCHES == 1
    p.ph_lo = 0; p.ph_hi = NPHASE;
    hipLaunchKernelGGL(fwd, dim3(grid), dim3(512), LDS_BYTES, stream, p);
#else
    for (int k = 0; k < NPHASE; ++k) { p.ph_lo = k; p.ph_hi = k + 1; hipLaunchKernelGGL(fwd, dim3(grid), dim3(512), LDS_BYTES, stream, p); }
#endif
}
```

```cpp
#include <hip/hip_runtime.h>
#include <cstdio>
#include <cstdint>

#ifndef MK_N_LAUNCHES
#define MK_N_LAUNCHES 1
#endif

#ifndef MOE_FP8
#define MOE_FP8 1
#endif
#define MOE_EB (MOE_FP8 ? 1 : 2)
#define LAS __attribute__((address_space(3)))
#define GAS __attribute__((address_space(1)))
typedef unsigned short bf16_t;
typedef short bf16x8 __attribute__((ext_vector_type(8)));
typedef short s16x4 __attribute__((ext_vector_type(4)));
typedef float f32x2 __attribute__((ext_vector_type(2)));
typedef float f32x4 __attribute__((ext_vector_type(4)));
typedef float f32x16 __attribute__((ext_vector_type(16)));
typedef unsigned u32x2 __attribute__((ext_vector_type(2)));
typedef unsigned u32x4 __attribute__((ext_vector_type(4)));
typedef __bf16 bf16x2_t __attribute__((ext_vector_type(2)));

constexpr int NTOK = 16384, DM = 2048, SEQ = 4096, NB = 4;
constexpr int INW = 12800;
constexpr int NEXP = 32, DFF = 2048;
constexpr float RMS_EPS = 1e-5f;
constexpr float LOG2E = 1.4426950408889634f;
constexpr float C2 = 0.125f * LOG2E;
constexpr int MAXT = 320;
constexpr float SC_W = MOE_FP8 ? 256.0f : 1.0f, SC_X = MOE_FP8 ? 16.0f : 1.0f, SC_ACT = MOE_FP8 ? 4.0f : 1.0f;

constexpr size_t MiB = 1u << 20;
constexpr size_t WS_CTL = 0, CTL_BYTES = 1 * MiB;
constexpr size_t WS_WIN_T = 1 * MiB;
constexpr size_t WS_WBR_T = WS_WIN_T + (size_t)INW * DM * 2;
constexpr size_t WS_WO_T  = WS_WBR_T + (size_t)2 * DM * DM * 2;
constexpr size_t WS_WGU_T = WS_WO_T + (size_t)DM * DM * 2;
constexpr size_t WS_WDN_T = WS_WGU_T + (size_t)NEXP * 2 * DFF * DM * 2;
constexpr size_t WS_XN    = WS_WDN_T + (size_t)NEXP * DM * DFF * 2;
constexpr size_t WS_RQ    = WS_XN + (size_t)NTOK * DM * 2;
constexpr size_t WS_RK    = WS_RQ + (size_t)NTOK * 1024 * 2;
constexpr size_t WS_RV    = WS_RK + (size_t)NTOK * 1024 * 2;
constexpr size_t WS_RG    = WS_RV + (size_t)NTOK * DM * 2;
constexpr size_t WS_SQ    = WS_RG + (size_t)NTOK * DM * 2;
constexpr size_t WS_SK    = WS_SQ + (size_t)NTOK * DM * 2;
constexpr size_t WS_SV    = WS_SK + (size_t)NTOK * 256 * 2;
constexpr size_t WS_GATES = WS_SV + (size_t)NTOK * 256 * 2;
constexpr size_t WS_COSR  = WS_GATES + (size_t)NTOK * 4096 * 2;
constexpr size_t WS_SINR  = WS_COSR + (size_t)NTOK * 64 * 4;
constexpr size_t WS_COSS  = WS_SINR + (size_t)NTOK * 64 * 4;
constexpr size_t WS_SINS  = WS_COSS + (size_t)NTOK * 32 * 4;
constexpr size_t WS_UT    = WS_SINS + (size_t)NTOK * 32 * 4;
constexpr size_t WS_PNT   = WS_UT + (size_t)NB * 32 * 8 * 256 * 128 * 4;
constexpr size_t WS_BR    = WS_PNT + (size_t)NB * 32 * 8 * 256 * 128 * 2;
constexpr size_t WS_MIX   = WS_BR + (size_t)2 * NTOK * DM * 2;
constexpr size_t WS_H2    = WS_MIX + (size_t)NTOK * DM * 2;
constexpr size_t WS_A2N   = WS_H2 + (size_t)NTOK * DM * 4;
constexpr size_t WS_TOKE  = WS_A2N + (size_t)NTOK * DM * 2;
constexpr size_t WS_TOKR  = WS_TOKE + (size_t)NTOK * 4 * 4;
constexpr size_t WS_TOKW  = WS_TOKR + (size_t)NTOK * 4 * 4;
constexpr size_t WS_LIST  = WS_TOKW + (size_t)NTOK * 4 * 4;
constexpr size_t WS_ACT   = WS_LIST + (size_t)NEXP * NTOK * 4;
constexpr size_t WS_Y     = WS_ACT + (size_t)MAXT * 256 * DFF * 2;
constexpr size_t WS_END   = WS_Y + (size_t)MAXT * 256 * DM * 2;

constexpr int CW_CNT = 64;
constexpr int CW_BAR = 4096;

constexpr int LDS_BYTES = 163840;
constexpr int MISC_OFF = 163840 - 4096;

__device__ __forceinline__ int lane_id() { int l; asm volatile("v_mbcnt_lo_u32_b32 %0, -1, 0\n\tv_mbcnt_hi_u32_b32 %0, -1, %0" : "=v"(l)); return l; }
#define TIDX (WID_ * 64 + lane_id())
__device__ __forceinline__ unsigned cvt_pk(float lo, float hi) { f32x2 v = {lo, hi}; bf16x2_t b = __builtin_convertvector(v, bf16x2_t); return __builtin_bit_cast(unsigned, b); }
__device__ __forceinline__ float bf_lo(unsigned w) { return __uint_as_float(w << 16); }
__device__ __forceinline__ float bf_hi(unsigned w) { return __uint_as_float(w & 0xffff0000u); }
__device__ __forceinline__ int crow(int r, int hi) { return (r & 3) + 8 * (r >> 2) + 4 * hi; }
__device__ __forceinline__ s16x4 tr16(LAS const unsigned char* p) { typedef short v4i16_t __attribute__((ext_vector_type(4))); return __builtin_bit_cast(s16x4, __builtin_amdgcn_ds_read_tr16_b64_v4i16((LAS v4i16_t*)p)); }
__device__ __forceinline__ bf16x8 mk8(s16x4 lo, s16x4 hi) { return (bf16x8){lo[0], lo[1], lo[2], lo[3], hi[0], hi[1], hi[2], hi[3]}; }
typedef int v8i_t __attribute__((ext_vector_type(8)));
typedef int v4i_t __attribute__((ext_vector_type(4)));
__device__ __forceinline__ v8i_t cat8(bf16x8 a, bf16x8 b) { const v4i_t x = __builtin_bit_cast(v4i_t, a), y = __builtin_bit_cast(v4i_t, b); return (v8i_t){x[0], x[1], x[2], x[3], y[0], y[1], y[2], y[3]}; }
__device__ __forceinline__ v8i_t ldfrag(const LAS unsigned char* p) { const v4i_t x = *(const LAS v4i_t*)p, y = *(const LAS v4i_t*)(p + 1024); return (v8i_t){x[0], x[1], x[2], x[3], y[0], y[1], y[2], y[3]}; }
__device__ __forceinline__ bf16x8 lo4(v8i_t v) { return __builtin_bit_cast(bf16x8, (v4i_t){v[0], v[1], v[2], v[3]}); }
__device__ __forceinline__ bf16x8 hi4(v8i_t v) { return __builtin_bit_cast(bf16x8, (v4i_t){v[4], v[5], v[6], v[7]}); }
__device__ __forceinline__ float clamp448(float x) { return __builtin_fminf(__builtin_fmaxf(x, -448.0f), 448.0f); }
__device__ __forceinline__ unsigned pk_fp8x4(float a, float b, float c, float d) { int w = 0; w = __builtin_amdgcn_cvt_pk_fp8_f32(clamp448(a), clamp448(b), w, false); w = __builtin_amdgcn_cvt_pk_fp8_f32(clamp448(c), clamp448(d), w, true); return (unsigned)w; }
__device__ __forceinline__ float fast_sigmoid(float x) { return __builtin_amdgcn_rcpf(1.0f + __expf(-x)); }

namespace pg8 {
constexpr int BM = 256, BK = 64, HALF = 128, HTB = HALF * BK * 2, STAGE_BYTES = 8 * HTB, NXCD = 8, WGM = 8;
__host__ __device__ __forceinline__ int lds_byte(int r, int c) { const int st = (r >> 4) * 2 + (c >> 5), rr = r & 15, cc = c & 31, ob = rr * 64 + cc * 2; return st * 1024 + (ob ^ (((ob >> 9) & 1) << 5)); }
__host__ __device__ __forceinline__ void stage_rc(int b, int& R, int& C) { const int st = b / 1024, sb = b % 1024, swz = sb ^ (((sb >> 9) & 1) << 5); R = (st >> 1) * 16 + swz / 64; C = (st & 1) * 32 + (swz % 64) / 2; }
__host__ __device__ __forceinline__ int perm32(int rho) { const int n = rho >> 4, i = rho & 15; return 8 * (i >> 2) + 4 * n + (i & 3); }

struct Unit { int pm, pn; };

__device__ __forceinline__ bool tile_order(int L, int nM, int nN, int& pm, int& pn) {
    const int nwg = nM * nN; if (L >= nwg) return false;
    int wgid = L; { const int q = nwg / NXCD, r = nwg % NXCD, xcd = wgid % NXCD, off = wgid / NXCD; wgid = (xcd < r ? xcd * (q + 1) : r * (q + 1) + (xcd - r) * q) + off; }
    const int nig = WGM * nN, gid = wgid / nig, fm = gid * WGM, gsz = (nM - fm) < WGM ? (nM - fm) : WGM;
    pm = fm + ((wgid % nig) % gsz); pn = (wgid % nig) / gsz; return true;
}

template <class Epi, class Sched, bool FP8 = false>
__device__ __forceinline__ void gemm_phase(const int WID_, LAS unsigned char* lds, const void* Ap, const void* Btp, const int Kb, const Sched& S, const Epi& E) {
    const int wid = WID_, wr = wid >> 2, wc = wid & 3; const int tid = TIDX;
    const int nt = Kb / 128;
    unsigned voffA[2], voffB0;
    { int R, C; stage_rc(tid * 16, R, C); const int Rb = Epi::PERM ? ((R & ~31) + perm32(R & 31)) : R;
      voffA[0] = (unsigned)(R * Kb + C * 2); voffA[1] = voffA[0] + 64u * (unsigned)Kb; voffB0 = (unsigned)(Rb * Kb + C * 2); }
    const size_t kstep = (size_t)128;
    const size_t hstep = (size_t)HALF * Kb;
    const size_t tstep = 2 * hstep;
    const unsigned ldsb = (unsigned)__builtin_amdgcn_readfirstlane((int)(unsigned)(uintptr_t)lds) + (unsigned)wid * 1024u;
    const int aoff = lds_byte(wr * 64 + (tid & 15), ((tid & 63) >> 4) * 8), boff = lds_byte(wc * 32 + (tid & 15), ((tid & 63) >> 4) * 8);
#define PG8_SA(b, h) (((b) * 2 + (h)) * HTB)
#define PG8_SB(b, h) ((4 + (b) * 2 + (h)) * HTB)
#define PG8_STAGE(bufoff, gbase, v0, v1) do { unsigned keep_; \
        asm volatile("s_nop 4\n\ts_mov_b32 %0, m0\n\ts_mov_b32 m0, %3\n\ts_nop 0\n\tglobal_load_lds_dwordx4 %1, %5\n\ts_mov_b32 m0, %4\n\ts_nop 0\n\tglobal_load_lds_dwordx4 %2, %5\n\ts_mov_b32 m0, %0" \
            : "=&s"(keep_) : "v"(v0), "v"(v1), "s"(ldsb + (unsigned)(bufoff)), "s"(ldsb + (unsigned)(bufoff) + 8192u), "s"((const char*)(gbase)) : "memory"); } while (0)
#define PG8_STAGE1(bufoff, gbase, v0) do { unsigned keep_; \
        asm volatile("s_nop 4\n\ts_mov_b32 %0, m0\n\ts_mov_b32 m0, %2\n\ts_nop 0\n\tglobal_load_lds_dwordx4 %1, %4\n\ts_mov_b32 m0, %3\n\ts_nop 0\n\tglobal_load_lds_dwordx4 %1, %5\n\ts_mov_b32 m0, %0" \
            : "=&s"(keep_) : "v"(v0), "s"(ldsb + (unsigned)(bufoff)), "s"(ldsb + (unsigned)(bufoff) + 8192u), "s"((const char*)(gbase)), "s"((const char*)(gbase) + (size_t)64 * Kb) : "memory"); } while (0)
#define PG8_STAGE_A(bufoff, gbase, v0, v1) do { if constexpr (Sched::GATHER) { PG8_STAGE(bufoff, gbase, v0, v1); } else { PG8_STAGE1(bufoff, gbase, v0); } } while (0)
#define PG8_LDA(dst, b, h) do { _Pragma("unroll") for (int m = 0; m < 4; ++m) dst[m] = ldfrag(lds + PG8_SA(b, h) + aoff + m * 2048); } while (0)
#define PG8_LDB(dst, b, h) do { _Pragma("unroll") for (int n = 0; n < 2; ++n) dst[n] = ldfrag(lds + PG8_SB(b, h) + boff + n * 2048); } while (0)
#define PG8_MMA(ai, bj, At, Bt) do { __builtin_amdgcn_s_setprio(1); _Pragma("unroll") for (int m = 0; m < 4; ++m) _Pragma("unroll") for (int n = 0; n < 2; ++n) { \
        if constexpr (FP8) { acc[ai][bj][m][n] = __builtin_amdgcn_mfma_scale_f32_16x16x128_f8f6f4(Bt[n], At[m], acc[ai][bj][m][n], 0, 0, 0, 0x7f7f7f7f, 0, 0x7f7f7f7f); } \
        else { acc[ai][bj][m][n] = __builtin_amdgcn_mfma_f32_16x16x32_bf16(lo4(Bt[n]), lo4(At[m]), acc[ai][bj][m][n], 0, 0, 0); acc[ai][bj][m][n] = __builtin_amdgcn_mfma_f32_16x16x32_bf16(hi4(Bt[n]), hi4(At[m]), acc[ai][bj][m][n], 0, 0, 0); } } \
        __builtin_amdgcn_s_setprio(0); } while (0)
#define PG8_WAIT_V(n) asm volatile("s_waitcnt vmcnt(" #n ")" ::: "memory")
#define PG8_WAIT_L(n) asm volatile("s_waitcnt lgkmcnt(" #n ")" ::: "memory")
#define PG8_BAR __builtin_amdgcn_s_barrier()
#define PG8_SCHED __builtin_amdgcn_sched_barrier(0)
    Unit cur, nxt; int ui = 0;
    if (!S.next(0, cur)) return;
    f32x4 acc[2][2][4][2];
#pragma unroll
    for (int a = 0; a < 2; ++a)
#pragma unroll
        for (int b = 0; b < 2; ++b)
#pragma unroll
            for (int m = 0; m < 4; ++m)
#pragma unroll
                for (int n = 0; n < 2; ++n) acc[a][b][m][n] = (f32x4){0.f, 0.f, 0.f, 0.f};
    v8i_t At[4], B0[2], B1[2];
    const char* cAb0; const char* cAb1; const char* nAb0; const char* nAb1;
    int sc = 0;
#define PG8_STASH(bank) (lds + STAGE_BYTES + (bank) * 8192 + TIDX * 16)
#define PG8_ADESC(u, b0, b1, bank) do { \
        if constexpr (Sched::GATHER) { b0 = (const char*)Ap; b1 = (const char*)Ap; const int tz_ = TIDX; int R0_, C0_, R1_, C1_; stage_rc(tz_ * 16, R0_, C0_); stage_rc(tz_ * 16 + 8192, R1_, C1_); \
            u32x4 o_; o_.x = (unsigned)S.row_token(u, R0_) * (unsigned)Kb + (unsigned)(C0_ * 2); o_.y = (unsigned)S.row_token(u, R1_) * (unsigned)Kb + (unsigned)(C1_ * 2); \
            o_.z = (unsigned)S.row_token(u, HALF + R0_) * (unsigned)Kb + (unsigned)(C0_ * 2); o_.w = (unsigned)S.row_token(u, HALF + R1_) * (unsigned)Kb + (unsigned)(C1_ * 2); \
            *(LAS u32x4*)PG8_STASH(bank) = o_; } \
        else { b0 = (const char*)Ap + (size_t)(u).pm * tstep; b1 = b0 + hstep; } } while (0)
#define PG8_AOFF(h, bank, o0, o1) unsigned o0, o1; do { if constexpr (Sched::GATHER) { const u32x2 t_ = *(const LAS u32x2*)(PG8_STASH(bank) + (h) * 8); o0 = t_.x; o1 = t_.y; } else { o0 = voffA[0]; o1 = voffA[1]; } } while (0)
    PG8_ADESC(cur, cAb0, cAb1, 0);
    const char* cB = (const char*)Btp + (size_t)cur.pn * tstep;
    { PG8_AOFF(0, 0, p00, p01); PG8_AOFF(1, 0, p10, p11);
    PG8_STAGE1(PG8_SB(0, 0), cB, voffB0); PG8_STAGE1(PG8_SB(0, 1), cB + hstep, voffB0); PG8_STAGE_A(PG8_SA(0, 0), cAb0, p00, p01); PG8_STAGE_A(PG8_SA(0, 1), cAb1, p10, p11);
    if (wr == 1) PG8_BAR;
    PG8_WAIT_V(2); PG8_BAR;
    PG8_STAGE1(PG8_SB(1, 0), cB + kstep, voffB0); PG8_STAGE_A(PG8_SA(1, 0), cAb0 + kstep, p00, p01); PG8_STAGE1(PG8_SB(1, 1), cB + hstep + kstep, voffB0);
    PG8_WAIT_V(6); PG8_BAR; }
    for (;;) {
        const bool has_next = S.next(ui + 1, nxt);
        if (has_next) { PG8_ADESC(nxt, nAb0, nAb1, sc ^ 1); } else { nAb0 = cAb0; nAb1 = cAb1; }
        const int nbank = has_next ? (sc ^ 1) : sc;
        const char* nB = has_next ? (const char*)Btp + (size_t)nxt.pn * tstep : cB;
        for (int t = 0; t < nt; t += 2) {
            const bool last = (t == nt - 2);
            const int xb = last ? nbank : sc;
            const char* a1h1 = cAb1 + (size_t)(t + 1) * kstep;
            const char* a2h0 = last ? nAb0 : cAb0 + (size_t)(t + 2) * kstep; const char* a2h1 = last ? nAb1 : cAb1 + (size_t)(t + 2) * kstep;
            const char* b2 = last ? nB : cB + (size_t)(t + 2) * kstep;
            const char* a3h0 = a2h0 + kstep; const char* b3 = b2 + kstep;
            { PG8_AOFF(1, sc, q0, q1); PG8_LDB(B0, 0, 0); PG8_LDB(B1, 0, 1); PG8_SCHED; PG8_LDA(At, 0, 0); PG8_STAGE_A(PG8_SA(1, 1), a1h1, q0, q1); }
            PG8_WAIT_V(8); PG8_WAIT_L(0); PG8_BAR; PG8_MMA(0, 0, At, B0); PG8_MMA(0, 1, At, B1); PG8_BAR; PG8_SCHED;
            { PG8_AOFF(0, xb, q0, q1); PG8_LDA(At, 0, 1); PG8_STAGE1(PG8_SB(0, 0), b2, voffB0); PG8_STAGE1(PG8_SB(0, 1), b2 + hstep, voffB0); PG8_STAGE_A(PG8_SA(0, 0), a2h0, q0, q1); }
            PG8_WAIT_V(8); PG8_WAIT_L(0); PG8_BAR; PG8_MMA(1, 0, At, B0); PG8_MMA(1, 1, At, B1); PG8_BAR; PG8_SCHED;
            { PG8_AOFF(1, xb, q0, q1); PG8_LDB(B0, 1, 0); PG8_LDB(B1, 1, 1); PG8_SCHED; PG8_LDA(At, 1, 0); PG8_STAGE_A(PG8_SA(0, 1), a2h1, q0, q1); }
            PG8_WAIT_V(8); PG8_WAIT_L(0); PG8_BAR; PG8_MMA(0, 0, At, B0); PG8_MMA(0, 1, At, B1); PG8_BAR; PG8_SCHED;
            { PG8_AOFF(0, xb, q0, q1); PG8_LDA(At, 1, 1); PG8_STAGE1(PG8_SB(1, 0), b3, voffB0); PG8_STAGE1(PG8_SB(1, 1), b3 + hstep, voffB0); PG8_STAGE_A(PG8_SA(1, 0), a3h0, q0, q1); }
            PG8_WAIT_V(8); PG8_WAIT_L(0); PG8_BAR; PG8_MMA(1, 0, At, B0); PG8_MMA(1, 1, At, B1); PG8_BAR; PG8_SCHED;
        }
        if (wr == 0) PG8_BAR;
        { const int l2_ = lane_id(); E(acc, cur, wr, wc, l2_ & 15, l2_ >> 4); }
        if (!has_next) break;
#pragma unroll
        for (int a = 0; a < 2; ++a)
#pragma unroll
            for (int b = 0; b < 2; ++b)
#pragma unroll
                for (int m = 0; m < 4; ++m)
#pragma unroll
                    for (int n = 0; n < 2; ++n) acc[a][b][m][n] = (f32x4){0.f, 0.f, 0.f, 0.f};
        cur = nxt; cAb0 = nAb0; cAb1 = nAb1; cB = nB; ++ui; sc ^= 1;
        if (wr == 1) PG8_BAR;
    }
    PG8_WAIT_V(0);
    PG8_BAR;
#undef PG8_ADESC
#undef PG8_AOFF
#undef PG8_STASH
#undef PG8_SA
#undef PG8_SB
#undef PG8_STAGE
#undef PG8_STAGE1
#undef PG8_STAGE_A
#undef PG8_LDA
#undef PG8_LDB
#undef PG8_MMA
#undef PG8_WAIT_V
#undef PG8_WAIT_L
#undef PG8_BAR
#undef PG8_SCHED
}
}
using pg8::Unit;

#define XB_TMO      128
#define XB_XCNT(j)  (256  + 64 * (j))
#define XB_XSUB(j)  (1280 + 64 * (j))
#define XB_XGEN(j)  (2304 + 64 * (j))
#define XB_TOP      3328
#define XB_TOPGEN   3392
#define XCD_BAR_WORDS 3456
#define XB_SPIN_CAP (1u << 18)

__device__ __forceinline__ unsigned xb_ld(unsigned* p)              { return __hip_atomic_load(p, __ATOMIC_RELAXED, __HIP_MEMORY_SCOPE_AGENT); }
__device__ __forceinline__ unsigned xb_add(unsigned* p, unsigned v) { return __hip_atomic_fetch_add(p, v, __ATOMIC_RELAXED, __HIP_MEMORY_SCOPE_AGENT); }
__device__ __forceinline__ unsigned xb_xcc_id() { return (unsigned)__builtin_amdgcn_s_getreg((3 << 11) | 20) & 0xFu; }
#define XB_SPIN(cond, bar) do { unsigned _sp = 0; while (cond) { __builtin_amdgcn_s_sleep(1); \
    if ((++_sp & 255u) == 0u) { if (xb_ld(&(bar)[XB_TMO])) break; if (_sp > XB_SPIN_CAP) { atomicAdd(&(bar)[XB_TMO], 1u); break; } } } } while (0)

struct XcdBarrier { unsigned* bar; unsigned x; volatile LAS unsigned* st; };

__device__ __forceinline__ XcdBarrier xcd_barrier_post(const int WID_, unsigned* bar, volatile LAS unsigned* st) {
    XcdBarrier b; b.bar = bar; b.x = xb_xcc_id(); b.st = st;
    if (TIDX == 0) (void)xb_add(&bar[XB_XCNT(b.x)], 1u);
    return b;
}
__device__ __forceinline__ void xcd_barrier_complete(unsigned* bar, unsigned x, unsigned& nloc, unsigned& nx) {
    const unsigned G = gridDim.x * gridDim.y * gridDim.z;
    unsigned sum, cnt, mine, sp = 0u;
    for (;;) {
        sum = 0u; cnt = 0u; mine = 0u;
#pragma unroll
        for (unsigned j = 0; j < 16; ++j) { const unsigned c = xb_ld(&bar[XB_XCNT(j)]); sum += c; cnt += (c > 0u) ? 1u : 0u; mine = (j == x) ? c : mine; }
        if (sum == G) break;
        __builtin_amdgcn_s_sleep(1);
        if ((++sp & 255u) == 0u) { if (xb_ld(&bar[XB_TMO])) break; if (sp > XB_SPIN_CAP) { atomicAdd(&bar[XB_TMO], 1u); break; } }
    }
    nloc = mine > 0u ? mine : 1u; nx = cnt > 0u ? cnt : 1u;
}
__device__ __forceinline__ void xcd_barrier(const int WID_, const XcdBarrier& b) {
    asm volatile("s_waitcnt vmcnt(0)" ::: "memory");
    __syncthreads();
    if (TIDX == 0) {
        unsigned* bar = b.bar;
        __builtin_amdgcn_s_waitcnt(0);
        unsigned nloc = b.st[0], nx = b.st[1];
        if (nloc == 0u) { xcd_barrier_complete(bar, b.x, nloc, nx); b.st[0] = nloc; b.st[1] = nx; }
        const unsigned old = xb_add(&bar[XB_XSUB(b.x)], 1u);
        const unsigned gen = old / nloc;
        if (old + 1u == (gen + 1u) * nloc) {
            __builtin_amdgcn_fence(__ATOMIC_RELEASE, "agent");
            asm volatile("s_waitcnt vmcnt(0)" ::: "memory");
            const unsigned og = xb_add(&bar[XB_TOP], 1u);
            const unsigned tg = og / nx;
            if (og + 1u == (tg + 1u) * nx) xb_add(&bar[XB_TOPGEN], 1u);
            else XB_SPIN(xb_ld(&bar[XB_TOPGEN]) == tg, bar);
            __builtin_amdgcn_fence(__ATOMIC_ACQUIRE, "agent");
            xb_add(&bar[XB_XGEN(b.x)], 1u);
            asm volatile("s_waitcnt vmcnt(0)" ::: "memory");
        } else {
            XB_SPIN(xb_ld(&bar[XB_XGEN(b.x)]) == gen, bar);
            __builtin_amdgcn_fence(__ATOMIC_ACQUIRE, "agent");
            asm volatile("s_waitcnt vmcnt(0)" ::: "memory");
        }
    }
    __syncthreads();
}

struct Params {
    const float* x; const int* positions; const float* attn_norm_w; const float* w_in; const float* gate_bias; const float* w_ret_out; const float* w_swa_out; const float* w_o;
    const float* sinks; const float* ffn_norm_w; const float* router_w; const float* router_b; const float* w_gate_up; const float* b_gate_up; const float* w_down; const float* b_down;
    const float* final_norm_w; float* out; unsigned char* ws; int ph_lo, ph_hi;
};

struct StaticOrder {
    static constexpr bool GATHER = false;
    int nM, nN, G, c;
    __device__ __forceinline__ bool next(int i, Unit& u) const { return pg8::tile_order(i * G + c, nM, nN, u.pm, u.pn); }
    __device__ __forceinline__ int row_token(const Unit&, int) const { return 0; }
};
struct MixOrder {
    static constexpr bool GATHER = false;
    int G, c;
    __device__ __forceinline__ bool next(int i, Unit& u) const { int pm, pn; if (!pg8::tile_order((i >> 1) * G + c, 64, 8, pm, pn)) return false; const int br = i & 1; u.pm = br * 64 + pm; u.pn = br * 8 + pn; return true; }
    __device__ __forceinline__ int row_token(const Unit&, int) const { return 0; }
};
template <bool GATH> struct MoeOrder {
    static constexpr bool GATHER = GATH;
    int T, nN, G, c; const LAS int* cnt; const LAS int* tile0; const LAS int* mte; const int* list;
    __device__ __forceinline__ bool next(int i, Unit& u) const { int pm, pn; if (!pg8::tile_order(i * G + c, T, nN, pm, pn)) return false; const int e = __builtin_amdgcn_readfirstlane(mte[pm]); u.pm = pm; u.pn = e * nN + pn; return true; }
    __device__ __forceinline__ int row_token(const Unit& u, int row) const {
        const int e = u.pn / nN; const int t0 = __builtin_amdgcn_readfirstlane(tile0[e]), ce = __builtin_amdgcn_readfirstlane(cnt[e]);
        int rank = (u.pm - t0) * 256 + row; rank = rank < ce ? rank : ce - 1; return list[e * NTOK + rank]; }
};

struct EpiProj {
    static constexpr bool PERM = true;
    unsigned char* ws; const float* gate_bias;
    __device__ __forceinline__ void operator()(const f32x4 (&acc)[2][2][4][2], const Unit& u, int wr, int wc, int fr, int fq) const {
        const int ct = u.pn; const int row0 = u.pm * 256 + wr * 64 + fr; const int cw = wc * 32 + 8 * fq;
        if (ct < 8) {
            bf16_t* dst = (bf16_t*)(ws + (ct < 4 ? WS_RQ : WS_RK)); const int colt = (ct & 3) * 256; const float sc = ct < 4 ? 1.0f : 0.08838834764831845f; const int f0 = 16 * wc + 4 * fq;
            const float* cosr = (const float*)(ws + WS_COSR); const float* sinr = (const float*)(ws + WS_SINR);
#pragma unroll
            for (int ai = 0; ai < 2; ++ai)
#pragma unroll
                for (int m = 0; m < 4; ++m) { const int row = row0 + ai * 128 + m * 16;
                    const f32x4 c = *(const f32x4*)(cosr + (size_t)row * 64 + f0) * sc, s = *(const f32x4*)(sinr + (size_t)row * 64 + f0) * sc;
#pragma unroll
                    for (int bj = 0; bj < 2; ++bj) { const f32x4 v0 = acc[ai][bj][m][0], v1 = acc[ai][bj][m][1]; const f32x4 o1 = v0 * c - v1 * s, o2 = v1 * c + v0 * s;
                        u32x4 w; w.x = cvt_pk(o1[0], o1[1]); w.y = cvt_pk(o1[2], o1[3]); w.z = cvt_pk(o2[0], o2[1]); w.w = cvt_pk(o2[2], o2[3]);
                        *(u32x4*)(dst + (size_t)row * 1024 + colt + bj * 128 + cw) = w; } }
        } else if ((ct >= 24 && ct < 33)) {
            bf16_t* dst = (bf16_t*)(ws + (ct < 32 ? WS_SQ : WS_SK)); const float* coss = (const float*)(ws + WS_COSS); const float* sins = (const float*)(ws + WS_SINS); const int ldc = ct < 32 ? 2048 : 256; const int colt = ct < 32 ? (ct - 24) * 256 : 0; const float sc = ct < 32 ? C2 : 1.0f; const int f0 = 16 * (wc & 1) + 4 * fq;
#pragma unroll
            for (int ai = 0; ai < 2; ++ai)
#pragma unroll
                for (int m = 0; m < 4; ++m) { const int row = row0 + ai * 128 + m * 16;
                    const f32x4 c = *(const f32x4*)(coss + (size_t)row * 32 + f0) * sc, s = *(const f32x4*)(sins + (size_t)row * 32 + f0) * sc;
#pragma unroll
                    for (int bj = 0; bj < 2; ++bj) { const f32x4 v0 = acc[ai][bj][m][0], v1 = acc[ai][bj][m][1]; const f32x4 o1 = v0 * c - v1 * s, o2 = v1 * c + v0 * s;
                        u32x4 w; w.x = cvt_pk(o1[0], o1[1]); w.y = cvt_pk(o1[2], o1[3]); w.z = cvt_pk(o2[0], o2[1]); w.w = cvt_pk(o2[2], o2[3]);
                        *(u32x4*)(dst + (size_t)row * ldc + colt + bj * 128 + cw) = w; } }
        } else if (ct >= 34) {
            const int colt = (ct - 34) * 256; bf16_t* gates = (bf16_t*)(ws + WS_GATES);
            f32x4 b0[2], b1[2];
#pragma unroll
            for (int bj = 0; bj < 2; ++bj) { b0[bj] = *(const f32x4*)(gate_bias + colt + bj * 128 + cw); b1[bj] = *(const f32x4*)(gate_bias + colt + bj * 128 + cw + 4); }
#pragma unroll
            for (int ai = 0; ai < 2; ++ai)
#pragma unroll
                for (int m = 0; m < 4; ++m) { const int row = row0 + ai * 128 + m * 16;
#pragma unroll
                    for (int bj = 0; bj < 2; ++bj) { const f32x4 v0 = acc[ai][bj][m][0] + b0[bj], v1 = acc[ai][bj][m][1] + b1[bj];
                        u32x4 w; w.x = cvt_pk(fast_sigmoid(v0[0]), fast_sigmoid(v0[1])); w.y = cvt_pk(fast_sigmoid(v0[2]), fast_sigmoid(v0[3]));
                        w.z = cvt_pk(fast_sigmoid(v1[0]), fast_sigmoid(v1[1])); w.w = cvt_pk(fast_sigmoid(v1[2]), fast_sigmoid(v1[3]));
                        *(u32x4*)(gates + (size_t)row * 4096 + colt + bj * 128 + cw) = w; } }
        } else {
            const bool act = (ct >= 16 && ct < 24);
            bf16_t* dst = (bf16_t*)(ws + (ct < 16 ? WS_RV : (ct < 24 ? WS_RG : WS_SV))); const int ldc = ct == 33 ? 256 : 2048; const int colt = ct < 16 ? (ct - 8) * 256 : (ct < 24 ? (ct - 16) * 256 : 0);
#pragma unroll
            for (int ai = 0; ai < 2; ++ai)
#pragma unroll
                for (int m = 0; m < 4; ++m) { const int row = row0 + ai * 128 + m * 16;
#pragma unroll
                    for (int bj = 0; bj < 2; ++bj) { f32x4 v0 = acc[ai][bj][m][0], v1 = acc[ai][bj][m][1];
                        if (act) {
#pragma unroll
                            for (int j = 0; j < 4; ++j) { v0[j] = v0[j] * fast_sigmoid(v0[j]); v1[j] = v1[j] * fast_sigmoid(v1[j]); } }
                        u32x4 w; w.x = cvt_pk(v0[0], v0[1]); w.y = cvt_pk(v0[2], v0[3]); w.z = cvt_pk(v1[0], v1[1]); w.w = cvt_pk(v1[2], v1[3]);
                        *(u32x4*)(dst + (size_t)row * ldc + colt + bj * 128 + cw) = w; } }
        }
    }
};
struct EpiMix {
    static constexpr bool PERM = true;
    const bf16_t* gates; bf16_t* mix;
    __device__ __forceinline__ void operator()(const f32x4 (&acc)[2][2][4][2], const Unit& u, int wr, int wc, int fr, int fq) const {
        const int br = u.pm >> 6, pm = u.pm & 63, ct = u.pn & 7; const int row0 = pm * 256 + wr * 64 + fr; const int col0 = ct * 256 + wc * 32 + 8 * fq;
#pragma unroll
        for (int ai = 0; ai < 2; ++ai)
#pragma unroll
            for (int m = 0; m < 4; ++m) { const int row = row0 + ai * 128 + m * 16;
#pragma unroll
                for (int bj = 0; bj < 2; ++bj) { const int col = col0 + bj * 128;
                    const u32x4 g = *(const u32x4*)(gates + (size_t)row * 4096 + br * 2048 + col);
                    f32x4 v0 = acc[ai][bj][m][0], v1 = acc[ai][bj][m][1];
                    v0[0] *= bf_lo(g.x); v0[1] *= bf_hi(g.x); v0[2] *= bf_lo(g.y); v0[3] *= bf_hi(g.y); v1[0] *= bf_lo(g.z); v1[1] *= bf_hi(g.z); v1[2] *= bf_lo(g.w); v1[3] *= bf_hi(g.w);
                    bf16_t* dp = mix + (size_t)row * 2048 + col;
                    if (br) { const u32x4 t = *(const u32x4*)dp;
                        v0[0] += bf_lo(t.x); v0[1] += bf_hi(t.x); v0[2] += bf_lo(t.y); v0[3] += bf_hi(t.y); v1[0] += bf_lo(t.z); v1[1] += bf_hi(t.z); v1[2] += bf_lo(t.w); v1[3] += bf_hi(t.w); }
                    u32x4 w; w.x = cvt_pk(v0[0], v0[1]); w.y = cvt_pk(v0[2], v0[3]); w.z = cvt_pk(v1[0], v1[1]); w.w = cvt_pk(v1[2], v1[3]);
                    *(u32x4*)dp = w; } }
    }
};
struct EpiResid {
    static constexpr bool PERM = false;
    const float* x; float* h2;
    __device__ __forceinline__ void operator()(const f32x4 (&acc)[2][2][4][2], const Unit& u, int wr, int wc, int fr, int fq) const {
        const int row0 = u.pm * 256 + wr * 64 + fr, col0 = u.pn * 256 + wc * 32 + 4 * fq;
#pragma unroll
        for (int ai = 0; ai < 2; ++ai)
#pragma unroll
            for (int m = 0; m < 4; ++m) { const size_t off = (size_t)(row0 + ai * 128 + m * 16) * 2048 + col0;
#pragma unroll
                for (int bj = 0; bj < 2; ++bj)
#pragma unroll
                    for (int n = 0; n < 2; ++n) { const f32x4 xv = *(const f32x4*)(x + off + bj * 128 + n * 16); *(f32x4*)(h2 + off + bj * 128 + n * 16) = xv + acc[ai][bj][m][n]; } }
    }
};
struct EpiSwiglu {
    static constexpr bool PERM = true;
    const float* b_gate_up; bf16_t* act;
    __device__ __forceinline__ void operator()(const f32x4 (&acc)[2][2][4][2], const Unit& u, int wr, int wc, int fr, int fq) const {
        const int e = u.pn >> 4, ct = u.pn & 15; const int row0 = u.pm * 256 + wr * 64 + fr; const int col0 = ct * 256 + wc * 32 + 8 * fq;
        f32x4 b0[2], b1[2];
#pragma unroll
        for (int bj = 0; bj < 2; ++bj) { b0[bj] = *(const f32x4*)(b_gate_up + (size_t)e * 4096 + col0 + bj * 128); b1[bj] = *(const f32x4*)(b_gate_up + (size_t)e * 4096 + col0 + bj * 128 + 4); }
#pragma unroll
        for (int ai = 0; ai < 2; ++ai)
#pragma unroll
            for (int m = 0; m < 4; ++m) { const int row = row0 + ai * 128 + m * 16;
#pragma unroll
                for (int bj = 0; bj < 2; ++bj) { const f32x4 v0 = acc[ai][bj][m][0] * (1.0f / (SC_W * SC_X)) + b0[bj], v1 = acc[ai][bj][m][1] * (1.0f / (SC_W * SC_X)) + b1[bj];
                    float a[4];
#pragma unroll
                    for (int j = 0; j < 4; ++j) { const float gt = fminf(j < 2 ? v0[2 * j] : v1[2 * j - 4], 7.0f); const float ln = fminf(fmaxf(j < 2 ? v0[2 * j + 1] : v1[2 * j - 3], -7.0f), 7.0f);
                        a[j] = gt * fast_sigmoid(1.702f * gt) * (ln + 1.0f); }
                    if constexpr (MOE_FP8 != 0) { *(unsigned*)((unsigned char*)act + (size_t)row * 2048 + ((col0 + bj * 128) >> 1)) = pk_fp8x4(a[0] * SC_ACT, a[1] * SC_ACT, a[2] * SC_ACT, a[3] * SC_ACT); }
                    else { u32x2 w; w.x = cvt_pk(a[0], a[1]); w.y = cvt_pk(a[2], a[3]); *(u32x2*)(act + (size_t)row * 2048 + ((col0 + bj * 128) >> 1)) = w; } } }
    }
};
struct EpiDown {
    static constexpr bool PERM = true;
    const float* b_down; bf16_t* y;
    __device__ __forceinline__ void operator()(const f32x4 (&acc)[2][2][4][2], const Unit& u, int wr, int wc, int fr, int fq) const {
        const int e = u.pn >> 3, ct = u.pn & 7; const int row0 = u.pm * 256 + wr * 64 + fr; const int col0 = ct * 256 + wc * 32 + 8 * fq;
        f32x4 b0[2], b1[2];
#pragma unroll
        for (int bj = 0; bj < 2; ++bj) { b0[bj] = *(const f32x4*)(b_down + (size_t)e * 2048 + col0 + bj * 128); b1[bj] = *(const f32x4*)(b_down + (size_t)e * 2048 + col0 + bj * 128 + 4); }
#pragma unroll
        for (int ai = 0; ai < 2; ++ai)
#pragma unroll
            for (int m = 0; m < 4; ++m) { const int row = row0 + ai * 128 + m * 16;
#pragma unroll
                for (int bj = 0; bj < 2; ++bj) { const f32x4 v0 = acc[ai][bj][m][0] * (1.0f / (SC_W * SC_ACT)) + b0[bj], v1 = acc[ai][bj][m][1] * (1.0f / (SC_W * SC_ACT)) + b1[bj];
                    u32x4 w; w.x = cvt_pk(v0[0], v0[1]); w.y = cvt_pk(v0[2], v0[3]); w.z = cvt_pk(v1[0], v1[1]); w.w = cvt_pk(v1[2], v1[3]);
                    *(u32x4*)(y + (size_t)row * 2048 + col0 + bj * 128) = w; } }
    }
};

__device__ __forceinline__ float wave_sum(float v) {
#pragma unroll
    for (int o = 1; o < 64; o <<= 1) v += __shfl_xor(v, o);
    return v;
}
__device__ __forceinline__ int win_src_col4(int n) {
    if (n < 2048) { const int p = n & 127; return (n & ~127) + ((p >> 2) & 1) * 64 + 4 * (p >> 3); }
    if (n >= 6144 && n < 8448) { const int p = n & 63; return (n & ~63) + ((p >> 2) & 1) * 32 + 4 * (p >> 3); }
    return n;
}
__device__ __forceinline__ void p0_transpose_tile(const float* W, int N, bf16_t* WT, int K, int k0, int n0, int srccol, LAS float* scr, int lane) {
    f32x4 v[16];
#pragma unroll
    for (int i = 0; i < 16; ++i) v[i] = *(const f32x4*)(W + (size_t)(k0 + (lane >> 4) + 4 * i) * N + srccol);
#pragma unroll
    for (int i = 0; i < 16; ++i) { LAS float* d = scr + ((lane >> 4) + 4 * i) * 65 + 4 * (lane & 15); d[0] = v[i][0]; d[1] = v[i][1]; d[2] = v[i][2]; d[3] = v[i][3]; }
    asm volatile("s_waitcnt lgkmcnt(0)" ::: "memory");
    const int c = lane & 7;
#pragma unroll
    for (int j = 0; j < 8; ++j) { const int n = (lane >> 3) + 8 * j; const LAS float* s = scr + (8 * c) * 65 + n;
        u32x4 o; o.x = cvt_pk(s[0], s[65]); o.y = cvt_pk(s[2 * 65], s[3 * 65]); o.z = cvt_pk(s[4 * 65], s[5 * 65]); o.w = cvt_pk(s[6 * 65], s[7 * 65]);
        *(u32x4*)(WT + (size_t)(n0 + n) * K + k0 + 8 * c) = o; }
    asm volatile("s_waitcnt lgkmcnt(0)" ::: "memory");
}
__device__ __forceinline__ void p0_transpose_tile_fp8(const float* W, int N, unsigned char* WT, int K, int k0, int n0, int srccol, LAS float* scr, int lane) {
    f32x4 v[16];
#pragma unroll
    for (int i = 0; i < 16; ++i) v[i] = *(const f32x4*)(W + (size_t)(k0 + (lane >> 4) + 4 * i) * N + srccol);
#pragma unroll
    for (int i = 0; i < 16; ++i) { LAS float* d = scr + ((lane >> 4) + 4 * i) * 65 + 4 * (lane & 15); d[0] = v[i][0]; d[1] = v[i][1]; d[2] = v[i][2]; d[3] = v[i][3]; }
    asm volatile("s_waitcnt lgkmcnt(0)" ::: "memory");
    const int c = lane & 3;
#pragma unroll
    for (int j = 0; j < 4; ++j) { const int n = (lane >> 2) + 16 * j; const LAS float* s = scr + (16 * c) * 65 + n;
        u32x4 o; o.x = pk_fp8x4(s[0] * SC_W, s[65] * SC_W, s[2 * 65] * SC_W, s[3 * 65] * SC_W); o.y = pk_fp8x4(s[4 * 65] * SC_W, s[5 * 65] * SC_W, s[6 * 65] * SC_W, s[7 * 65] * SC_W);
        o.z = pk_fp8x4(s[8 * 65] * SC_W, s[9 * 65] * SC_W, s[10 * 65] * SC_W, s[11 * 65] * SC_W); o.w = pk_fp8x4(s[12 * 65] * SC_W, s[13 * 65] * SC_W, s[14 * 65] * SC_W, s[15 * 65] * SC_W);
        *(u32x4*)(WT + (size_t)(n0 + n) * K + k0 + 16 * c) = o; }
    asm volatile("s_waitcnt lgkmcnt(0)" ::: "memory");
}
__device__ __forceinline__ void p0_prologue(const int WID_, const Params& p, LAS unsigned char* lds, int vcu, int G) {
    const int tid = TIDX, lane = tid & 63, wave = WID_;
    LAS float* scr = (LAS float*)(lds + wave * 16640);
    const int gw = vcu * 8 + wave, NGW = G * 8;
    unsigned char* ws = p.ws;
    constexpr int T_IN = 32 * 200, T_SQ = 32 * 32, T_GU = 32 * 32 * 64, T_DN = 32 * 32 * 32;
    constexpr int NT_ALL = T_IN + 3 * T_SQ + T_GU + T_DN;
    for (int it = gw; it < NT_ALL; it += NGW) {
        int r = it;
        if (r < T_IN) { const int kb = r / 200, nb = r % 200; const int n0 = nb * 64; p0_transpose_tile(p.w_in, INW, (bf16_t*)(ws + WS_WIN_T), DM, kb * 64, n0, win_src_col4(n0 + 4 * (lane & 15)), scr, lane); continue; } r -= T_IN;
        if (r < 3 * T_SQ) { const int w = r / T_SQ; r -= w * T_SQ; const int kb = r / 32, nb = r % 32; const float* W = w == 0 ? p.w_ret_out : (w == 1 ? p.w_swa_out : p.w_o);
            bf16_t* WT = w == 2 ? (bf16_t*)(ws + WS_WO_T) : (bf16_t*)(ws + WS_WBR_T) + (size_t)w * DM * DM;
            p0_transpose_tile(W, DM, WT, DM, kb * 64, nb * 64, nb * 64 + 4 * (lane & 15), scr, lane); continue; } r -= 3 * T_SQ;
        if (r < T_GU) { const int e = r / 2048; r -= e * 2048; const int kb = r / 64, nb = r % 64;
            if constexpr (MOE_FP8 != 0) p0_transpose_tile_fp8(p.w_gate_up + (size_t)e * DM * 4096, 4096, ws + WS_WGU_T + (size_t)e * 4096 * DM, DM, kb * 64, nb * 64, nb * 64 + 4 * (lane & 15), scr, lane);
            else p0_transpose_tile(p.w_gate_up + (size_t)e * DM * 4096, 4096, (bf16_t*)(ws + WS_WGU_T) + (size_t)e * 4096 * DM, DM, kb * 64, nb * 64, nb * 64 + 4 * (lane & 15), scr, lane);
            continue; } r -= T_GU;
        { const int e = r / 1024; r -= e * 1024; const int kb = r / 32, nb = r % 32;
            if constexpr (MOE_FP8 != 0) p0_transpose_tile_fp8(p.w_down + (size_t)e * DFF * DM, DM, ws + WS_WDN_T + (size_t)e * DM * DFF, DFF, kb * 64, nb * 64, nb * 64 + 4 * (lane & 15), scr, lane);
            else p0_transpose_tile(p.w_down + (size_t)e * DFF * DM, DM, (bf16_t*)(ws + WS_WDN_T) + (size_t)e * DM * DFF, DFF, kb * 64, nb * 64, nb * 64 + 4 * (lane & 15), scr, lane); }
    }
    for (int m = gw; m < NTOK; m += NGW) {
        const f32x4* xr = (const f32x4*)(p.x + (size_t)m * DM) + lane; const f32x4* wr = (const f32x4*)p.attn_norm_w + lane;
        f32x4 v[8]; float s = 0.f;
#pragma unroll
        for (int j = 0; j < 8; ++j) { v[j] = xr[64 * j]; s += (v[j][0] * v[j][0] + v[j][1] * v[j][1]) + (v[j][2] * v[j][2] + v[j][3] * v[j][3]); }
        const float rs = rsqrtf(wave_sum(s) * (1.0f / DM) + RMS_EPS);
        u32x2* o8 = (u32x2*)((bf16_t*)(ws + WS_XN) + (size_t)m * DM) + lane;
#pragma unroll
        for (int j = 0; j < 8; ++j) { const f32x4 w = wr[64 * j]; u32x2 o; o.x = cvt_pk(v[j][0] * rs * w[0], v[j][1] * rs * w[1]); o.y = cvt_pk(v[j][2] * rs * w[2], v[j][3] * rs * w[3]); o8[64 * j] = o; }
    }
    const int gt = (vcu * 512 + tid), NGT = G * 512;
    for (int i = gt; i < NTOK * 96; i += NGT) {
        const int tok = i / 96, f = i % 96; const float pos = (float)p.positions[tok];
        float inv; if (f < 64) inv = expf(-9.210340371976184f * (float)(2 * f) * (1.0f / 128.0f)); else inv = expf(-9.210340371976184f * (float)(2 * (f - 64)) * (1.0f / 64.0f));
        const float ang = pos * inv; float sn, cs; sincosf(ang, &sn, &cs);
        if (f < 64) { ((float*)(ws + WS_COSR))[(size_t)tok * 64 + f] = cs; ((float*)(ws + WS_SINR))[(size_t)tok * 64 + f] = sn; }
        else { ((float*)(ws + WS_COSS))[(size_t)tok * 32 + f - 64] = cs; ((float*)(ws + WS_SINS))[(size_t)tok * 32 + f - 64] = sn; }
    }
}

__device__ __forceinline__ float ret_l2g(int h) { return log1pf(-exp2f(-5.0f - (float)h)) * LOG2E; }

__device__ __forceinline__ void ret_u_unit(const int WID_, LAS unsigned char* lds, const bf16_t* RK, const bf16_t* RV, float* UT, int b, int n, int h) {
    const int tid = TIDX, lane = tid & 63, r32 = lane & 31, hi = lane >> 5; const int wid = WID_;
    const size_t tok0 = (size_t)b * SEQ + (size_t)n * 128;
    const float l2g = ret_l2g(h);
#pragma unroll
    for (int i = 0; i < 4; ++i) { const int x = tid + 512 * i, ch = x & 15, row = x >> 4;
        const u32x4 v = *(const u32x4*)(RK + (tok0 + row) * 1024 + h * 128 + ch * 8);
        *(LAS u32x4*)(lds + (ch >> 2) * 8192 + row * 64 + (ch & 3) * 16) = v; }
#pragma unroll
    for (int i = 0; i < 8; ++i) { const int x = tid + 512 * i, ch = x & 31, row = x >> 5;
        u32x4 v = *(const u32x4*)(RV + (tok0 + row) * 2048 + h * 256 + ch * 8);
        const float z = exp2f(l2g * (float)(127 - row));
        v.x = cvt_pk(bf_lo(v.x) * z, bf_hi(v.x) * z); v.y = cvt_pk(bf_lo(v.y) * z, bf_hi(v.y) * z); v.z = cvt_pk(bf_lo(v.z) * z, bf_hi(v.z) * z); v.w = cvt_pk(bf_lo(v.w) * z, bf_hi(v.w) * z);
        *(LAS u32x4*)(lds + 32768 + (ch >> 2) * 8192 + row * 64 + (ch & 3) * 16) = v; }
    __syncthreads();
    const int trb = (8 * hi + ((lane & 15) >> 2)) * 64 + ((lane >> 4) & 1) * 32 + (lane & 3) * 8;
    f32x16 acc[4];
#pragma unroll
    for (int c = 0; c < 4; ++c) acc[c] = (f32x16){};
#pragma unroll 2
    for (int ks = 0; ks < 8; ++ks) {
        const LAS unsigned char* ap = lds + 32768 + wid * 8192 + ks * 1024 + trb;
        const bf16x8 af = mk8(tr16(ap), tr16(ap + 256));
#pragma unroll
        for (int c = 0; c < 4; ++c) { const LAS unsigned char* bp = lds + c * 8192 + ks * 1024 + trb; const bf16x8 bfr = mk8(tr16(bp), tr16(bp + 256));
            acc[c] = __builtin_amdgcn_mfma_f32_32x32x16_bf16(af, bfr, acc[c], 0, 0, 0); }
    }
    float* up = UT + ((((size_t)b * 32 + n) * 8 + h) * 256 + 32 * wid) * 128;
#pragma unroll
    for (int c = 0; c < 4; ++c)
#pragma unroll
        for (int r = 0; r < 16; ++r) up[(size_t)crow(r, hi) * 128 + 32 * c + r32] = acc[c][r];
    __syncthreads();
}

__device__ __forceinline__ void swa_unit(const int WID_, LAS unsigned char* lds, const bf16_t* SQ, const bf16_t* SK, const bf16_t* SV, const float* sinks, bf16_t* SWAO, int b, int kvh, int n) {
    const int tid = TIDX, lane = tid & 63, r32 = lane & 31, hi = lane >> 5; const int wid = WID_;
    const long tokq = (long)b * SEQ + (long)n * 128; const long band0 = tokq - 128;
#pragma unroll
    for (int i = 0; i < 4; ++i) { const int x = tid + 512 * i, ch = x & 7, row = x >> 3; long tk = band0 + row; if (tk < 0) tk = 0;
        const u32x4 kv = *(const u32x4*)(SK + tk * 256 + kvh * 64 + ch * 8); const u32x4 vv = *(const u32x4*)(SV + tk * 256 + kvh * 64 + ch * 8);
        *(LAS u32x4*)(lds + ch * 4096 + row * 16) = kv;
        *(LAS u32x4*)(lds + 32768 + (ch >> 2) * 16384 + row * 64 + (ch & 3) * 16) = vv; }
    __syncthreads();
    const int qh = kvh * 8 + wid; const float sink2 = sinks[qh] * LOG2E;
    const int trb = (4 * hi + ((lane & 15) >> 2)) * 64 + ((lane >> 4) & 1) * 32 + (lane & 3) * 8;
    for (int s = 0; s < 4; ++s) {
        bf16x8 qr[4];
#pragma unroll
        for (int d0 = 0; d0 < 4; ++d0) qr[d0] = *(const bf16x8*)(SQ + (size_t)(tokq + 32 * s + r32) * 2048 + qh * 64 + 16 * d0 + 8 * hi);
        const int t_lo = s < 2 ? 0 : 1;
        f32x16 pt[3][2];
#pragma unroll
        for (int tt = 0; tt < 3; ++tt)
#pragma unroll
            for (int hf = 0; hf < 2; ++hf) { f32x16 a = (f32x16){};
                const LAS unsigned char* kp = lds + hi * 4096 + (64 * (t_lo + tt) + 32 * hf + r32) * 16;
#pragma unroll
                for (int d0 = 0; d0 < 4; ++d0) { const bf16x8 kf = *(const LAS bf16x8*)(kp + d0 * 8192); a = __builtin_amdgcn_mfma_f32_32x32x16_bf16(kf, qr[d0], a, 0, 0, 0); }
                pt[tt][hf] = a; }
        const int iq = 32 * s + r32; float mx = sink2;
#pragma unroll
        for (int tt = 0; tt < 3; ++tt)
#pragma unroll
            for (int hf = 0; hf < 2; ++hf)
#pragma unroll
                for (int r = 0; r < 16; ++r) { const int jp = 64 * (t_lo + tt) + 32 * hf + crow(r, hi);
                    const bool valid = (jp > iq) && (jp <= iq + 128) && (n > 0 || jp >= 128);
                    const float v = valid ? pt[tt][hf][r] : -INFINITY; pt[tt][hf][r] = v; mx = fmaxf(mx, v); }
        mx = fmaxf(mx, __shfl_xor(mx, 32));
        float l = 0.f;
#pragma unroll
        for (int tt = 0; tt < 3; ++tt)
#pragma unroll
            for (int hf = 0; hf < 2; ++hf)
#pragma unroll
                for (int r = 0; r < 16; ++r) { const float e = exp2f(pt[tt][hf][r] - mx); pt[tt][hf][r] = e; l += e; }
        l += __shfl_xor(l, 32); l += exp2f(sink2 - mx);
        const float linv = 1.0f / l;
        f32x16 o[2]; o[0] = (f32x16){}; o[1] = (f32x16){};
#pragma unroll
        for (int tt = 0; tt < 3; ++tt)
#pragma unroll
            for (int hf = 0; hf < 2; ++hf)
#pragma unroll
                for (int k2 = 0; k2 < 2; ++k2) {
                    u32x4 pw; pw.x = cvt_pk(pt[tt][hf][8 * k2 + 0], pt[tt][hf][8 * k2 + 1]); pw.y = cvt_pk(pt[tt][hf][8 * k2 + 2], pt[tt][hf][8 * k2 + 3]);
                    pw.z = cvt_pk(pt[tt][hf][8 * k2 + 4], pt[tt][hf][8 * k2 + 5]); pw.w = cvt_pk(pt[tt][hf][8 * k2 + 6], pt[tt][hf][8 * k2 + 7]);
                    const bf16x8 pa = __builtin_bit_cast(bf16x8, pw);
                    const int krow = 64 * (t_lo + tt) + 32 * hf + 16 * k2;
#pragma unroll
                    for (int d0 = 0; d0 < 2; ++d0) { const LAS unsigned char* vp = lds + 32768 + d0 * 16384 + krow * 64 + trb; const bf16x8 vf = mk8(tr16(vp), tr16(vp + 512));
                        o[d0] = __builtin_amdgcn_mfma_f32_32x32x16_bf16(pa, vf, o[d0], 0, 0, 0); }
                }
        bf16_t* op = SWAO + (size_t)(tokq + 32 * s) * 2048 + qh * 64 + r32;
#pragma unroll
        for (int r = 0; r < 16; ++r) { const int q = crow(r, hi); const float li = __shfl(linv, q);
            op[(size_t)q * 2048] = (bf16_t)(cvt_pk(o[0][r] * li, 0.f) & 0xffffu); op[(size_t)q * 2048 + 32] = (bf16_t)(cvt_pk(o[1][r] * li, 0.f) & 0xffffu); }
    }
    __syncthreads();
}

__device__ __forceinline__ void ret_scan(const int WID_, const float* UT, bf16_t* PNT, int vcu, int G) {
    const int gt = vcu * 512 + TIDX, NGT = G * 512;
    for (int idx = gt; idx < NB * 8 * 256 * 32; idx += NGT) {
        const int d4 = idx & 31, e = (idx >> 5) & 255, h = (idx >> 13) & 7, b = idx >> 16;
        const float dec = exp2f(ret_l2g(h) * 128.0f);
        f32x4 P = (f32x4){0.f, 0.f, 0.f, 0.f};
#pragma unroll 8
        for (int n = 0; n < 32; ++n) { const size_t off = ((((size_t)b * 32 + n) * 8 + h) * 256 + e) * 128 + 4 * d4;
            u32x2 o; o.x = cvt_pk(P[0], P[1]); o.y = cvt_pk(P[2], P[3]); *(u32x2*)(PNT + off) = o;
            if (n < 31) { const f32x4 U = *(const f32x4*)(UT + off); P = P * dec + U; } }
    }
}

__device__ __forceinline__ void ret_out_unit(const int WID_, LAS unsigned char* lds, const bf16_t* RQ, const bf16_t* RK, const bf16_t* RV, const bf16_t* RG, const bf16_t* PNT, bf16_t* RETO, int b, int n, int h) {
    const int tid = TIDX, lane = tid & 63, r32 = lane & 31, hi = lane >> 5; const int wid = WID_;
    const size_t tok0 = (size_t)b * SEQ + (size_t)n * 128;
    const float l2g = ret_l2g(h);
#pragma unroll
    for (int i = 0; i < 4; ++i) { const int x = tid + 512 * i, ch = x & 15, row = x >> 4;
        const u32x4 v = *(const u32x4*)(RK + (tok0 + row) * 1024 + h * 128 + ch * 8);
        *(LAS u32x4*)(lds + ch * 2048 + row * 16) = v; }
#pragma unroll
    for (int i = 0; i < 8; ++i) { const int x = tid + 512 * i, ch = x & 31, row = x >> 5;
        const u32x4 v = *(const u32x4*)(RV + (tok0 + row) * 2048 + h * 256 + ch * 8);
        *(LAS u32x4*)(lds + 32768 + (ch >> 2) * 8192 + row * 64 + (ch & 3) * 16) = v; }
    __syncthreads();
    const int rb = wid & 3, eh = wid >> 2;
    bf16x8 qr[8];
#pragma unroll
    for (int d0 = 0; d0 < 8; ++d0) qr[d0] = *(const bf16x8*)(RQ + (tok0 + 32 * rb + r32) * 1024 + h * 128 + 16 * d0 + 8 * hi);
    f32x16 o[4];
#pragma unroll
    for (int c = 0; c < 4; ++c) o[c] = (f32x16){};
    if (n > 0) {
        const bf16_t* pp = PNT + ((((size_t)b * 32 + n) * 8 + h) * 256 + 128 * eh + r32) * 128 + 8 * hi;
#pragma unroll
        for (int d0 = 0; d0 < 8; ++d0) {
#pragma unroll
            for (int c = 0; c < 4; ++c) { const bf16x8 bfr = *(const bf16x8*)(pp + (size_t)(32 * c) * 128 + 16 * d0); o[c] = __builtin_amdgcn_mfma_f32_32x32x16_bf16(qr[d0], bfr, o[c], 0, 0, 0); }
            if (d0 & 1) asm volatile("" ::: "memory"); }
#pragma unroll
        for (int r = 0; r < 16; ++r) { const float xi = exp2f(l2g * (float)(32 * rb + crow(r, hi) + 1));
#pragma unroll
            for (int c = 0; c < 4; ++c) o[c][r] *= xi; }
    }
    const int trb = (4 * hi + ((lane & 15) >> 2)) * 64 + ((lane >> 4) & 1) * 32 + (lane & 3) * 8;
    for (int jb = 0; jb <= rb; ++jb) {
        f32x16 st = (f32x16){};
        const LAS unsigned char* kp = lds + hi * 2048 + (32 * jb + r32) * 16;
#pragma unroll
        for (int d0 = 0; d0 < 8; ++d0) { const bf16x8 kf = *(const LAS bf16x8*)(kp + d0 * 4096); st = __builtin_amdgcn_mfma_f32_32x32x16_bf16(kf, qr[d0], st, 0, 0, 0); }
        const int iq = 32 * rb + r32;
#pragma unroll
        for (int r = 0; r < 16; ++r) { const int j = 32 * jb + crow(r, hi); const int dd = iq - j; st[r] = dd >= 0 ? st[r] * exp2f(l2g * (float)dd) : 0.f; }
#pragma unroll
        for (int k2 = 0; k2 < 2; ++k2) {
            u32x4 pw; pw.x = cvt_pk(st[8 * k2 + 0], st[8 * k2 + 1]); pw.y = cvt_pk(st[8 * k2 + 2], st[8 * k2 + 3]); pw.z = cvt_pk(st[8 * k2 + 4], st[8 * k2 + 5]); pw.w = cvt_pk(st[8 * k2 + 6], st[8 * k2 + 7]);
            const bf16x8 pa = __builtin_bit_cast(bf16x8, pw);
            const int krow = 32 * jb + 16 * k2;
#pragma unroll
            for (int c = 0; c < 4; ++c) { const LAS unsigned char* vp = lds + 32768 + (4 * eh + c) * 8192 + krow * 64 + trb; const bf16x8 vf = mk8(tr16(vp), tr16(vp + 512));
                o[c] = __builtin_amdgcn_mfma_f32_32x32x16_bf16(pa, vf, o[c], 0, 0, 0); }
        }
    }
    float ss[16];
#pragma unroll
    for (int r = 0; r < 16; ++r) { float a = 0.f;
#pragma unroll
        for (int c = 0; c < 4; ++c) a += o[c][r] * o[c][r];
        a += __shfl_xor(a, 1); a += __shfl_xor(a, 2); a += __shfl_xor(a, 4); a += __shfl_xor(a, 8); a += __shfl_xor(a, 16); ss[r] = a; }
    __syncthreads();
    LAS float* sx = (LAS float*)(lds + 98304);
    if (r32 == 0) {
#pragma unroll
        for (int r = 0; r < 16; ++r) sx[wid * 32 + crow(r, hi)] = ss[r]; }
    __syncthreads();
    const bf16_t* gp = RG + (tok0 + 32 * rb) * 2048 + h * 256 + 128 * eh + r32;
    bf16_t* op = RETO + (tok0 + 32 * rb) * 2048 + h * 256 + 128 * eh + r32;
#pragma unroll
    for (int r = 0; r < 16; ++r) { const int q = crow(r, hi); const float tot = ss[r] + sx[(wid ^ 4) * 32 + q]; const float rstd = rsqrtf(tot * (1.0f / 256.0f) + RMS_EPS);
#pragma unroll
        for (int c = 0; c < 4; ++c) { const float g = __uint_as_float((unsigned)gp[(size_t)q * 2048 + 32 * c] << 16);
            op[(size_t)q * 2048 + 32 * c] = (bf16_t)(cvt_pk(o[c][r] * rstd * g, 0.f) & 0xffffu); } }
    __syncthreads();
}

__device__ __forceinline__ void p5_router(const int WID_, const Params& p, LAS unsigned char* lds, int blk) {
    const int tid = TIDX, lane = tid & 63, r32 = lane & 31, hi = lane >> 5; const int wid = WID_;
    unsigned char* ws = p.ws; const float* H2 = (const float*)(ws + WS_H2);
    const int tok0 = blk * 64;
    LAS float* hc = (LAS float*)lds;
    LAS float* wc = (LAS float*)(lds + 65792);
    LAS float* ssr = (LAS float*)(lds + 98560);
    LAS int* cntl = (LAS int*)(lds + 98816);
    LAS int* gb = (LAS int*)(lds + 98944);
    LAS float* pl = (LAS float*)lds;
    if (tid < 32) cntl[tid] = 0;
    const int mt = wid & 1, ksub = wid >> 1;
    const int lrow = tid >> 3, lc0 = (tid & 7) * 32;
    f32x16 acc = (f32x16){}; float ssq = 0.f;
    for (int kc = 0; kc < 8; ++kc) {
#pragma unroll
        for (int j = 0; j < 8; ++j) { const f32x4 hv = *(const f32x4*)(H2 + (size_t)(tok0 + lrow) * DM + kc * 256 + lc0 + 4 * j); const f32x4 wv = *(const f32x4*)(p.ffn_norm_w + kc * 256 + lc0 + 4 * j);
            const f32x4 t = hv * wv; ssq += (hv[0] * hv[0] + hv[1] * hv[1]) + (hv[2] * hv[2] + hv[3] * hv[3]);
            LAS float* d = hc + lrow * 257 + lc0 + 4 * j; d[0] = t[0]; d[1] = t[1]; d[2] = t[2]; d[3] = t[3]; }
#pragma unroll
        for (int i = 0; i < 4; ++i) { const int x = tid + 512 * i, k = x >> 3, e4 = x & 7; *(LAS f32x4*)(wc + k * 32 + 4 * e4) = *(const f32x4*)(p.router_w + (size_t)(kc * 256 + k) * 32 + 4 * e4); }
        __syncthreads();
#pragma unroll 8
        for (int kk = 0; kk < 32; ++kk) { const int k0 = 64 * ksub + 2 * kk + hi; const float a = hc[(32 * mt + r32) * 257 + k0]; const float bb = wc[k0 * 32 + r32];
            acc = __builtin_amdgcn_mfma_f32_32x32x2f32(a, bb, acc, 0, 0, 0); }
        __syncthreads();
    }
    ssq += __shfl_xor(ssq, 1); ssq += __shfl_xor(ssq, 2); ssq += __shfl_xor(ssq, 4);
    if ((tid & 7) == 0) ssr[lrow] = ssq;
#pragma unroll
    for (int r = 0; r < 16; ++r) pl[wid * 1056 + crow(r, hi) * 33 + r32] = acc[r];
    __syncthreads();
    int te[4]; int lr[4]; float tw[4];
    if (tid < 64) {
        const int mt2 = tid >> 5, row = tid & 31; const float rs = rsqrtf(ssr[tid] * (1.0f / DM) + RMS_EPS);
        float v[32];
#pragma unroll
        for (int e = 0; e < 32; ++e) { float a = 0.f;
#pragma unroll
            for (int ks = 0; ks < 4; ++ks) a += pl[(mt2 + 2 * ks) * 1056 + row * 33 + e];
            v[e] = a * rs + p.router_b[e]; }
        float tv[4];
#pragma unroll
        for (int k = 0; k < 4; ++k) { float best = -INFINITY; int bi = 0;
#pragma unroll
            for (int e = 0; e < 32; ++e) if (v[e] > best) { best = v[e]; bi = e; }
#pragma unroll
            for (int e = 0; e < 32; ++e) if (e == bi) v[e] = -INFINITY;
            tv[k] = best; te[k] = bi; }
        float sum = 0.f;
#pragma unroll
        for (int k = 0; k < 4; ++k) { tw[k] = __expf(tv[k] - tv[0]); sum += tw[k]; }
        const float inv = 1.0f / sum;
#pragma unroll
        for (int k = 0; k < 4; ++k) { tw[k] *= inv; lr[k] = atomicAdd((int*)&cntl[te[k]], 1); }
    }
    __syncthreads();
    if (tid < 32) { const int c = cntl[tid]; int base = 0; if (c > 0) base = (int)atomicAdd((unsigned*)(ws + WS_CTL) + CW_CNT + tid, (unsigned)c); gb[tid] = base; }
    __syncthreads();
    if (tid < 64) { const int tok = tok0 + tid;
#pragma unroll
        for (int k = 0; k < 4; ++k) { const int rank = gb[te[k]] + lr[k];
            ((int*)(ws + WS_LIST))[(size_t)te[k] * NTOK + rank] = tok; ((int*)(ws + WS_TOKE))[tok * 4 + k] = te[k]; ((int*)(ws + WS_TOKR))[tok * 4 + k] = rank; ((float*)(ws + WS_TOKW))[tok * 4 + k] = tw[k]; } }
    for (int rr = 0; rr < 8; ++rr) { const int row = wid * 8 + rr; const float rs = rsqrtf(ssr[row] * (1.0f / DM) + RMS_EPS);
        const f32x4* hr = (const f32x4*)(H2 + (size_t)(tok0 + row) * DM) + lane; const f32x4* wr = (const f32x4*)p.ffn_norm_w + lane; u32x2* o8 = (u32x2*)((bf16_t*)(ws + WS_A2N) + (size_t)(tok0 + row) * DM) + lane;
#pragma unroll
        for (int j = 0; j < 8; ++j) { const f32x4 hv = hr[64 * j], wv = wr[64 * j];
            if constexpr (MOE_FP8 != 0) { ((unsigned*)(ws + WS_A2N + (size_t)(tok0 + row) * DM))[lane + 64 * j] = pk_fp8x4(hv[0] * rs * wv[0] * SC_X, hv[1] * rs * wv[1] * SC_X, hv[2] * rs * wv[2] * SC_X, hv[3] * rs * wv[3] * SC_X); }
            else { u32x2 o; o.x = cvt_pk(hv[0] * rs * wv[0], hv[1] * rs * wv[1]); o.y = cvt_pk(hv[2] * rs * wv[2], hv[3] * rs * wv[3]); o8[64 * j] = o; } } }
    __syncthreads();
}

__device__ __forceinline__ int moe_tables(const int WID_, const Params& p, LAS unsigned char* lds) {
    LAS int* cnt = (LAS int*)(lds + MISC_OFF + 64); LAS int* tile0 = (LAS int*)(lds + MISC_OFF + 192); LAS int* mte = (LAS int*)(lds + MISC_OFF + 512);
    const int tid = TIDX;
    if (tid < 32) cnt[tid] = (int)__hip_atomic_load((unsigned*)(p.ws + WS_CTL) + CW_CNT + tid, __ATOMIC_RELAXED, __HIP_MEMORY_SCOPE_AGENT);
    __syncthreads();
    if (tid == 0) { int t = 0; for (int e = 0; e < 32; ++e) { tile0[e] = t; const int nt = (cnt[e] + 255) >> 8; for (int j = 0; j < nt && t + j < MAXT; ++j) mte[t + j] = e; t += nt; if (t > MAXT) t = MAXT; } tile0[32] = t; }
    __syncthreads();
    return __builtin_amdgcn_readfirstlane(tile0[32]);
}

__device__ __forceinline__ void p8_final(const int WID_, const Params& p, LAS unsigned char* lds, int vcu, int G) {
    const int tid = TIDX, lane = tid & 63, wave = WID_;
    unsigned char* ws = p.ws; const LAS int* tile0 = (const LAS int*)(lds + MISC_OFF + 192);
    const int gw = vcu * 8 + wave, NGW = G * 8;
    for (int m = gw; m < NTOK; m += NGW) {
        const f32x4* hr = (const f32x4*)((const float*)(ws + WS_H2) + (size_t)m * DM) + lane;
        f32x4 v[8];
#pragma unroll
        for (int j = 0; j < 8; ++j) v[j] = hr[64 * j];
#pragma unroll
        for (int k = 0; k < 4; ++k) { const int e = ((const int*)(ws + WS_TOKE))[m * 4 + k], rank = ((const int*)(ws + WS_TOKR))[m * 4 + k]; const float w = ((const float*)(ws + WS_TOKW))[m * 4 + k];
            const size_t slot = (size_t)tile0[e] * 256 + rank; const u32x2* yr = (const u32x2*)((const bf16_t*)(ws + WS_Y) + slot * DM) + lane;
#pragma unroll
            for (int j = 0; j < 8; ++j) { const u32x2 y = yr[64 * j]; v[j][0] += w * bf_lo(y.x); v[j][1] += w * bf_hi(y.x); v[j][2] += w * bf_lo(y.y); v[j][3] += w * bf_hi(y.y); } }
        float s = 0.f;
#pragma unroll
        for (int j = 0; j < 8; ++j) s += (v[j][0] * v[j][0] + v[j][1] * v[j][1]) + (v[j][2] * v[j][2] + v[j][3] * v[j][3]);
        const float rs = rsqrtf(wave_sum(s) * (1.0f / DM) + RMS_EPS);
        const f32x4* wr = (const f32x4*)p.final_norm_w + lane; f32x4* orow = (f32x4*)(p.out + (size_t)m * DM) + lane;
#pragma unroll
        for (int j = 0; j < 8; ++j) orow[64 * j] = v[j] * rs * wr[64 * j];
    }
}

constexpr int NPHASE = 11;
__global__ void __launch_bounds__(512, 2) fwd(Params p) {
    extern __shared__ __attribute__((aligned(16))) unsigned char lds_raw[];
    LAS unsigned char* lds = (LAS unsigned char*)lds_raw;
    const int WID_ = __builtin_amdgcn_readfirstlane((int)threadIdx.x >> 6);
    const int tid = TIDX;
    const int G = gridDim.x; const int bx = blockIdx.x; const int vcu = (G % 8 == 0) ? (bx % 8) * (G / 8) + bx / 8 : bx;
    unsigned char* ws = p.ws;
    for (int u = tid; u < 1024; u += 512) ((LAS unsigned*)(lds + MISC_OFF))[u] = 0u;
    __syncthreads();
    XcdBarrier bar; bar.bar = (unsigned*)(ws + WS_CTL) + CW_BAR; bar.x = 0; bar.st = nullptr;
    const int lo = p.ph_lo, hi = p.ph_hi;
    if (hi - lo > 1) bar = xcd_barrier_post(WID_, (unsigned*)(ws + WS_CTL) + CW_BAR, (volatile LAS unsigned*)(lds + MISC_OFF));
#ifndef PHASE_MASK
#define PHASE_MASK 0x7ff
#endif
#define IN(k) (((PHASE_MASK >> (k)) & 1) && lo <= (k) && (k) < hi)
#define SEAM(k) do { if (IN(k) && IN((k) + 1)) xcd_barrier(WID_, bar); } while (0)

    bf16_t* XN = (bf16_t*)(ws + WS_XN); bf16_t* RQ = (bf16_t*)(ws + WS_RQ); bf16_t* RK = (bf16_t*)(ws + WS_RK); bf16_t* RV = (bf16_t*)(ws + WS_RV); bf16_t* RG = (bf16_t*)(ws + WS_RG);
    bf16_t* SQ = (bf16_t*)(ws + WS_SQ); bf16_t* SK = (bf16_t*)(ws + WS_SK); bf16_t* SV = (bf16_t*)(ws + WS_SV); bf16_t* GATES = (bf16_t*)(ws + WS_GATES);
    bf16_t* BR = (bf16_t*)(ws + WS_BR); bf16_t* MIX = (bf16_t*)(ws + WS_MIX);

    if (IN(0)) { p0_prologue(WID_, p, lds, vcu, G); }
    SEAM(0);
    if (IN(1)) {
        StaticOrder S{64, 50, G, bx};
        EpiProj E{ws, p.gate_bias};
        pg8::gemm_phase<EpiProj, StaticOrder>(WID_, lds, XN, (const bf16_t*)(ws + WS_WIN_T), DM * 2, S, E);
    }
    SEAM(1);
    if (IN(2)) {
        for (int it = vcu; it < NB * 31 * 8; it += G) { const int h = it & 7, n = (it >> 3) % 31, b = it / 248; ret_u_unit(WID_, lds, RK, RV, (float*)(ws + WS_UT), b, n, h); }
        for (int it = vcu; it < NB * 32 * 4; it += G) { const int kvh = it & 3, n = (it >> 2) & 31, b = it >> 7; swa_unit(WID_, lds, SQ, SK, SV, p.sinks, BR + (size_t)NTOK * DM, b, kvh, n); }
    }
    SEAM(2);
    if (IN(3)) { ret_scan(WID_, (const float*)(ws + WS_UT), (bf16_t*)(ws + WS_PNT), vcu, G); }
    SEAM(3);
    if (IN(4)) {
        for (int it = vcu; it < NB * 32 * 8; it += G) { const int h = it & 7, n = (it >> 3) & 31, b = it >> 8; ret_out_unit(WID_, lds, RQ, RK, RV, RG, (const bf16_t*)(ws + WS_PNT), BR, b, n, h); }
    }
    SEAM(4);
    if (IN(5)) {
        MixOrder S{G, bx}; EpiMix E{GATES, MIX};
        pg8::gemm_phase<EpiMix, MixOrder>(WID_, lds, BR, (const bf16_t*)(ws + WS_WBR_T), DM * 2, S, E);
    }
    SEAM(5);
    if (IN(6)) {
        StaticOrder S{64, 8, G, bx}; EpiResid E{p.x, (float*)(ws + WS_H2)};
        pg8::gemm_phase<EpiResid, StaticOrder>(WID_, lds, MIX, (const bf16_t*)(ws + WS_WO_T), DM * 2, S, E);
    }
    SEAM(6);
    if (IN(7)) { for (int blk = vcu; blk < NTOK / 64; blk += G) p5_router(WID_, p, lds, blk); }
    SEAM(7);
    if (IN(8)) {
        const int T = moe_tables(WID_, p, lds);
        MoeOrder<true> S{T, 16, G, bx, (const LAS int*)(lds + MISC_OFF + 64), (const LAS int*)(lds + MISC_OFF + 192), (const LAS int*)(lds + MISC_OFF + 512), (const int*)(ws + WS_LIST)};
        EpiSwiglu E{p.b_gate_up, (bf16_t*)(ws + WS_ACT)};
        pg8::gemm_phase<EpiSwiglu, MoeOrder<true>, MOE_FP8 != 0>(WID_, lds, ws + WS_A2N, ws + WS_WGU_T, DM * MOE_EB, S, E);
    }
    SEAM(8);
    if (IN(9)) {
        const int T = moe_tables(WID_, p, lds);
        MoeOrder<false> S{T, 8, G, bx, (const LAS int*)(lds + MISC_OFF + 64), (const LAS int*)(lds + MISC_OFF + 192), (const LAS int*)(lds + MISC_OFF + 512), (const int*)(ws + WS_LIST)};
        EpiDown E{p.b_down, (bf16_t*)(ws + WS_Y)};
        pg8::gemm_phase<EpiDown, MoeOrder<false>, MOE_FP8 != 0>(WID_, lds, ws + WS_ACT, ws + WS_WDN_T, DFF * MOE_EB, S, E);
    }
    SEAM(9);
    if (IN(10)) { (void)moe_tables(WID_, p, lds); p8_final(WID_, p, lds, vcu, G); }
#undef IN
#undef SEAM
}

extern "C" void kernel_launch(void* const* d_in, const int* in_sizes, int n_in, void* d_out, int out_size, void* d_ws, size_t ws_size, hipStream_t stream) {
    static int grid = 0;
    if (grid == 0) {
        if (n_in != 17 || out_size != NTOK * DM || ws_size < WS_END) { fprintf(stderr, "kernel_launch: unexpected shapes (n_in %d, out %d, ws %zu, need %zu)\n", n_in, out_size, ws_size, (size_t)WS_END); grid = -1; return; }
        int dev = 0, cus = 0;
        if (hipGetDevice(&dev) != hipSuccess || hipDeviceGetAttribute(&cus, hipDeviceAttributeMultiprocessorCount, dev) != hipSuccess) { grid = -1; return; }
        if (hipFuncSetAttribute((const void*)fwd, hipFuncAttributeMaxDynamicSharedMemorySize, LDS_BYTES) != hipSuccess) { fprintf(stderr, "kernel_launch: hipFuncSetAttribute failed\n"); grid = -1; return; }
        int per_cu = 0;
        if (hipOccupancyMaxActiveBlocksPerMultiprocessor(&per_cu, (const void*)fwd, 512, LDS_BYTES) != hipSuccess || per_cu < 1) fprintf(stderr, "kernel_launch: occupancy query reports %d\n", per_cu);
        (void)hipGetLastError();
        grid = cus;
    }
    if (grid < 0) return;
    (void)hipMemsetAsync((char*)d_ws + WS_CTL, 0, CTL_BYTES, stream);
    Params p{};
    p.x = (const float*)d_in[0]; p.positions = (const int*)d_in[1]; p.attn_norm_w = (const float*)d_in[2]; p.w_in = (const float*)d_in[3]; p.gate_bias = (const float*)d_in[4];
    p.w_ret_out = (const float*)d_in[5]; p.w_swa_out = (const float*)d_in[6]; p.w_o = (const float*)d_in[7]; p.sinks = (const float*)d_in[8]; p.ffn_norm_w = (const float*)d_in[9];
    p.router_w = (const float*)d_in[10]; p.router_b = (const float*)d_in[11]; p.w_gate_up = (const float*)d_in[12]; p.b_gate_up = (const float*)d_in[13]; p.w_down = (const float*)d_in[14];
    p.b_down = (const float*)d_in[15]; p.final_norm_w = (const float*)d_in[16]; p.out = (float*)d_out; p.ws = (unsigned char*)d_ws;
#if MK_N_LAUNCHES == 1
    p.ph_lo = 0; p.ph_hi = NPHASE;
    hipLaunchKernelGGL(fwd, dim3(grid), dim3(512), LDS_BYTES, stream, p);
#else
    for (int k = 0; k < NPHASE; ++k) { p.ph_lo = k; p.ph_hi = k + 1; hipLaunchKernelGGL(fwd, dim3(grid), dim3(512), LDS_BYTES, stream, p); }
#endif
}
```

```cpp
#include <hip/hip_runtime.h>
#include <cstdio>
#include <cstdint>

#ifndef MK_N_LAUNCHES
#define MK_N_LAUNCHES 1
#endif

#ifndef MOE_FP8
#define MOE_FP8 1
#endif
#define MOE_EB (MOE_FP8 ? 1 : 2)
#define LAS __attribute__((address_space(3)))
#define GAS __attribute__((address_space(1)))
typedef unsigned short bf16_t;
typedef short bf16x8 __attribute__((ext_vector_type(8)));
typedef short s16x4 __attribute__((ext_vector_type(4)));
typedef float f32x2 __attribute__((ext_vector_type(2)));
typedef float f32x4 __attribute__((ext_vector_type(4)));
typedef float f32x16 __attribute__((ext_vector_type(16)));
typedef unsigned u32x2 __attribute__((ext_vector_type(2)));
typedef unsigned u32x4 __attribute__((ext_vector_type(4)));
typedef __bf16 bf16x2_t __attribute__((ext_vector_type(2)));

constexpr int NTOK = 16384, DM = 2048, SEQ = 4096, NB = 4;
constexpr int INW = 12800;
constexpr int NEXP = 32, DFF = 2048;
constexpr float RMS_EPS = 1e-5f;
constexpr float LOG2E = 1.4426950408889634f;
constexpr float C2 = 0.125f * LOG2E;
constexpr int MAXT = 320;
constexpr float SC_W = MOE_FP8 ? 256.0f : 1.0f, SC_X = MOE_FP8 ? 16.0f : 1.0f, SC_ACT = MOE_FP8 ? 4.0f : 1.0f;

constexpr size_t MiB = 1u << 20;
constexpr size_t WS_CTL = 0, CTL_BYTES = 1 * MiB;
constexpr size_t WS_WIN_T = 1 * MiB;
constexpr size_t WS_WBR_T = WS_WIN_T + (size_t)INW * DM * 2;
constexpr size_t WS_WO_T  = WS_WBR_T + (size_t)2 * DM * DM * 2;
constexpr size_t WS_WGU_T = WS_WO_T + (size_t)DM * DM * 2;
constexpr size_t WS_WDN_T = WS_WGU_T + (size_t)NEXP * 2 * DFF * DM * 2;
constexpr size_t WS_XN    = WS_WDN_T + (size_t)NEXP * DM * DFF * 2;
constexpr size_t WS_RQ    = WS_XN + (size_t)NTOK * DM * 2;
constexpr size_t WS_RK    = WS_RQ + (size_t)NTOK * 1024 * 2;
constexpr size_t WS_RV    = WS_RK + (size_t)NTOK * 1024 * 2;
constexpr size_t WS_RG    = WS_RV + (size_t)NTOK * DM * 2;
constexpr size_t WS_SQ    = WS_RG + (size_t)NTOK * DM * 2;
constexpr size_t WS_SK    = WS_SQ + (size_t)NTOK * DM * 2;
constexpr size_t WS_SV    = WS_SK + (size_t)NTOK * 256 * 2;
constexpr size_t WS_GATES = WS_SV + (size_t)NTOK * 256 * 2;
constexpr size_t WS_COSR  = WS_GATES + (size_t)NTOK * 4096 * 2;
constexpr size_t WS_SINR  = WS_COSR + (size_t)NTOK * 64 * 4;
constexpr size_t WS_COSS  = WS_SINR + (size_t)NTOK * 64 * 4;
constexpr size_t WS_SINS  = WS_COSS + (size_t)NTOK * 32 * 4;
constexpr size_t WS_UT    = WS_SINS + (size_t)NTOK * 32 * 4;
constexpr size_t WS_PNT   = WS_UT + (size_t)NB * 32 * 8 * 256 * 128 * 4;
constexpr size_t WS_BR    = WS_PNT + (size_t)NB * 32 * 8 * 256 * 128 * 2;
constexpr size_t WS_MIX   = WS_BR + (size_t)2 * NTOK * DM * 2;
constexpr size_t WS_H2    = WS_MIX + (size_t)NTOK * DM * 2;
constexpr size_t WS_A2N   = WS_H2 + (size_t)NTOK * DM * 4;
constexpr size_t WS_TOKE  = WS_A2N + (size_t)NTOK * DM * 2;
constexpr size_t WS_TOKR  = WS_TOKE + (size_t)NTOK * 4 * 4;
constexpr size_t WS_TOKW  = WS_TOKR + (size_t)NTOK * 4 * 4;
constexpr size_t WS_LIST  = WS_TOKW + (size_t)NTOK * 4 * 4;
constexpr size_t WS_ACT   = WS_LIST + (size_t)NEXP * NTOK * 4;
constexpr size_t WS_Y     = WS_ACT + (size_t)MAXT * 256 * DFF * 2;
constexpr size_t WS_END   = WS_Y + (size_t)MAXT * 256 * DM * 2;

constexpr int CW_CNT = 64;
constexpr int CW_BAR = 4096;

constexpr int LDS_BYTES = 163840;
constexpr int MISC_OFF = 163840 - 4096;

__device__ __forceinline__ int lane_id() { int l; asm volatile("v_mbcnt_lo_u32_b32 %0, -1, 0\n\tv_mbcnt_hi_u32_b32 %0, -1, %0" : "=v"(l)); return l; }
#define TIDX (WID_ * 64 + lane_id())
__device__ __forceinline__ unsigned cvt_pk(float lo, float hi) { f32x2 v = {lo, hi}; bf16x2_t b = __builtin_convertvector(v, bf16x2_t); return __builtin_bit_cast(unsigned, b); }
__device__ __forceinline__ float bf_lo(unsigned w) { return __uint_as_float(w << 16); }
__device__ __forceinline__ float bf_hi(unsigned w) { return __uint_as_float(w & 0xffff0000u); }
__device__ __forceinline__ int crow(int r, int hi) { return (r & 3) + 8 * (r >> 2) + 4 * hi; }
__device__ __forceinline__ s16x4 tr16(LAS const unsigned char* p) { typedef short v4i16_t __attribute__((ext_vector_type(4))); return __builtin_bit_cast(s16x4, __builtin_amdgcn_ds_read_tr16_b64_v4i16((LAS v4i16_t*)p)); }
__device__ __forceinline__ bf16x8 mk8(s16x4 lo, s16x4 hi) { return (bf16x8){lo[0], lo[1], lo[2], lo[3], hi[0], hi[1], hi[2], hi[3]}; }
typedef int v8i_t __attribute__((ext_vector_type(8)));
typedef int v4i_t __attribute__((ext_vector_type(4)));
__device__ __forceinline__ v8i_t cat8(bf16x8 a, bf16x8 b) { const v4i_t x = __builtin_bit_cast(v4i_t, a), y = __builtin_bit_cast(v4i_t, b); return (v8i_t){x[0], x[1], x[2], x[3], y[0], y[1], y[2], y[3]}; }
__device__ __forceinline__ v8i_t ldfrag(const LAS unsigned char* p) { const v4i_t x = *(const LAS v4i_t*)p, y = *(const LAS v4i_t*)(p + 1024); return (v8i_t){x[0], x[1], x[2], x[3], y[0], y[1], y[2], y[3]}; }
__device__ __forceinline__ bf16x8 lo4(v8i_t v) { return __builtin_bit_cast(bf16x8, (v4i_t){v[0], v[1], v[2], v[3]}); }
__device__ __forceinline__ bf16x8 hi4(v8i_t v) { return __builtin_bit_cast(bf16x8, (v4i_t){v[4], v[5], v[6], v[7]}); }
__device__ __forceinline__ float clamp448(float x) { return __builtin_fminf(__builtin_fmaxf(x, -448.0f), 448.0f); }
__device__ __forceinline__ unsigned pk_fp8x4(float a, float b, float c, float d) { int w = 0; w = __builtin_amdgcn_cvt_pk_fp8_f32(clamp448(a), clamp448(b), w, false); w = __builtin_amdgcn_cvt_pk_fp8_f32(clamp448(c), clamp448(d), w, true); return (unsigned)w; }
__device__ __forceinline__ float fast_sigmoid(float x) { return __builtin_amdgcn_rcpf(1.0f + __expf(-x)); }

namespace pg8 {
constexpr int BM = 256, BK = 64, HALF = 128, HTB = HALF * BK * 2, STAGE_BYTES = 8 * HTB, NXCD = 8, WGM = 8;
__host__ __device__ __forceinline__ int lds_byte(int r, int c) { const int st = (r >> 4) * 2 + (c >> 5), rr = r & 15, cc = c & 31, ob = rr * 64 + cc * 2; return st * 1024 + (ob ^ (((ob >> 9) & 1) << 5)); }
__host__ __device__ __forceinline__ void stage_rc(int b, int& R, int& C) { const int st = b / 1024, sb = b % 1024, swz = sb ^ (((sb >> 9) & 1) << 5); R = (st >> 1) * 16 + swz / 64; C = (st & 1) * 32 + (swz % 64) / 2; }
__host__ __device__ __forceinline__ int perm32(int rho) { const int n = rho >> 4, i = rho & 15; return 8 * (i >> 2) + 4 * n + (i & 3); }

struct Unit { int pm, pn; };

__device__ __forceinline__ bool tile_order(int L, int nM, int nN, int& pm, int& pn) {
    const int nwg = nM * nN; if (L >= nwg) return false;
    int wgid = L; { const int q = nwg / NXCD, r = nwg % NXCD, xcd = wgid % NXCD, off = wgid / NXCD; wgid = (xcd < r ? xcd * (q + 1) : r * (q + 1) + (xcd - r) * q) + off; }
    const int nig = WGM * nN, gid = wgid / nig, fm = gid * WGM, gsz = (nM - fm) < WGM ? (nM - fm) : WGM;
    pm = fm + ((wgid % nig) % gsz); pn = (wgid % nig) / gsz; return true;
}

template <class Epi, class Sched, bool FP8 = false>
__device__ __forceinline__ void gemm_phase(const int WID_, LAS unsigned char* lds, const void* Ap, const void* Btp, const int Kb, const Sched& S, const Epi& E) {
    const int wid = WID_, wr = wid >> 2, wc = wid & 3; const int tid = TIDX;
    const int nt = Kb / 128;
    unsigned voffA[2], voffB0;
    { int R, C; stage_rc(tid * 16, R, C); const int Rb = Epi::PERM ? ((R & ~31) + perm32(R & 31)) : R;
      voffA[0] = (unsigned)(R * Kb + C * 2); voffA[1] = voffA[0] + 64u * (unsigned)Kb; voffB0 = (unsigned)(Rb * Kb + C * 2); }
    const size_t kstep = (size_t)128;
    const size_t hstep = (size_t)HALF * Kb;
    const size_t tstep = 2 * hstep;
    const unsigned ldsb = (unsigned)__builtin_amdgcn_readfirstlane((int)(unsigned)(uintptr_t)lds) + (unsigned)wid * 1024u;
    const int aoff = lds_byte(wr * 64 + (tid & 15), ((tid & 63) >> 4) * 8), boff = lds_byte(wc * 32 + (tid & 15), ((tid & 63) >> 4) * 8);
#define PG8_SA(b, h) (((b) * 2 + (h)) * HTB)
#define PG8_SB(b, h) ((4 + (b) * 2 + (h)) * HTB)
#define PG8_STAGE(bufoff, gbase, v0, v1) do { unsigned keep_; \
        asm volatile("s_nop 4\n\ts_mov_b32 %0, m0\n\ts_mov_b32 m0, %3\n\ts_nop 0\n\tglobal_load_lds_dwordx4 %1, %5\n\ts_mov_b32 m0, %4\n\ts_nop 0\n\tglobal_load_lds_dwordx4 %2, %5\n\ts_mov_b32 m0, %0" \
            : "=&s"(keep_) : "v"(v0), "v"(v1), "s"(ldsb + (unsigned)(bufoff)), "s"(ldsb + (unsigned)(bufoff) + 8192u), "s"((const char*)(gbase)) : "memory"); } while (0)
#define PG8_STAGE1(bufoff, gbase, v0) do { unsigned keep_; \
        asm volatile("s_nop 4\n\ts_mov_b32 %0, m0\n\ts_mov_b32 m0, %2\n\ts_nop 0\n\tglobal_load_lds_dwordx4 %1, %4\n\ts_mov_b32 m0, %3\n\ts_nop 0\n\tglobal_load_lds_dwordx4 %1, %5\n\ts_mov_b32 m0, %0" \
            : "=&s"(keep_) : "v"(v0), "s"(ldsb + (unsigned)(bufoff)), "s"(ldsb + (unsigned)(bufoff) + 8192u), "s"((const char*)(gbase)), "s"((const char*)(gbase) + (size_t)64 * Kb) : "memory"); } while (0)
#define PG8_STAGE_A(bufoff, gbase, v0, v1) do { if constexpr (Sched::GATHER) { PG8_STAGE(bufoff, gbase, v0, v1); } else { PG8_STAGE1(bufoff, gbase, v0); } } while (0)
#define PG8_LDA(dst, b, h) do { _Pragma("unroll") for (int m = 0; m < 4; ++m) dst[m] = ldfrag(lds + PG8_SA(b, h) + aoff + m * 2048); } while (0)
#define PG8_LDB(dst, b, h) do { _Pragma("unroll") for (int n = 0; n < 2; ++n) dst[n] = ldfrag(lds + PG8_SB(b, h) + boff + n * 2048); } while (0)
#define PG8_MMA(ai, bj, At, Bt) do { __builtin_amdgcn_s_setprio(1); _Pragma("unroll") for (int m = 0; m < 4; ++m) _Pragma("unroll") for (int n = 0; n < 2; ++n) { \
        if constexpr (FP8) { acc[ai][bj][m][n] = __builtin_amdgcn_mfma_scale_f32_16x16x128_f8f6f4(Bt[n], At[m], acc[ai][bj][m][n], 0, 0, 0, 0x7f7f7f7f, 0, 0x7f7f7f7f); } \
        else { acc[ai][bj][m][n] = __builtin_amdgcn_mfma_f32_16x16x32_bf16(lo4(Bt[n]), lo4(At[m]), acc[ai][bj][m][n], 0, 0, 0); acc[ai][bj][m][n] = __builtin_amdgcn_mfma_f32_16x16x32_bf16(hi4(Bt[n]), hi4(At[m]), acc[ai][bj][m][n], 0, 0, 0); } } \
        __builtin_amdgcn_s_setprio(0); } while (0)
#define PG8_WAIT_V(n) asm volatile("s_waitcnt vmcnt(" #n ")" ::: "memory")
#define PG8_WAIT_L(n) asm volatile("s_waitcnt lgkmcnt(" #n ")" ::: "memory")
#define PG8_BAR __builtin_amdgcn_s_barrier()
#define PG8_SCHED __builtin_amdgcn_sched_barrier(0)
    Unit cur, nxt; int ui = 0;
    if (!S.next(0, cur)) return;
    f32x4 acc[2][2][4][2];
#pragma unroll
    for (int a = 0; a < 2; ++a)
#pragma unroll
        for (int b = 0; b < 2; ++b)
#pragma unroll
            for (int m = 0; m < 4; ++m)
#pragma unroll
                for (int n = 0; n < 2; ++n) acc[a][b][m][n] = (f32x4){0.f, 0.f, 0.f, 0.f};
    v8i_t At[4], B0[2], B1[2];
    const char* cAb0; const char* cAb1; const char* nAb0; const char* nAb1;
    int sc = 0;
#define PG8_STASH(bank) (lds + STAGE_BYTES + (bank) * 8192 + TIDX * 16)
#define PG8_ADESC(u, b0, b1, bank) do { \
        if constexpr (Sched::GATHER) { b0 = (const char*)Ap; b1 = (const char*)Ap; const int tz_ = TIDX; int R0_, C0_, R1_, C1_; stage_rc(tz_ * 16, R0_, C0_); stage_rc(tz_ * 16 + 8192, R1_, C1_); \
            u32x4 o_; o_.x = (unsigned)S.row_token(u, R0_) * (unsigned)Kb + (unsigned)(C0_ * 2); o_.y = (unsigned)S.row_token(u, R1_) * (unsigned)Kb + (unsigned)(C1_ * 2); \
            o_.z = (unsigned)S.row_token(u, HALF + R0_) * (unsigned)Kb + (unsigned)(C0_ * 2); o_.w = (unsigned)S.row_token(u, HALF + R1_) * (unsigned)Kb + (unsigned)(C1_ * 2); \
            *(LAS u32x4*)PG8_STASH(bank) = o_; } \
        else { b0 = (const char*)Ap + (size_t)(u).pm * tstep; b1 = b0 + hstep; } } while (0)
#define PG8_AOFF(h, bank, o0, o1) unsigned o0, o1; do { if constexpr (Sched::GATHER) { const u32x2 t_ = *(const LAS u32x2*)(PG8_STASH(bank) + (h) * 8); o0 = t_.x; o1 = t_.y; } else { o0 = voffA[0]; o1 = voffA[1]; } } while (0)
    PG8_ADESC(cur, cAb0, cAb1, 0);
    const char* cB = (const char*)Btp + (size_t)cur.pn * tstep;
    { PG8_AOFF(0, 0, p00, p01); PG8_AOFF(1, 0, p10, p11);
    PG8_STAGE1(PG8_SB(0, 0), cB, voffB0); PG8_STAGE1(PG8_SB(0, 1), cB + hstep, voffB0); PG8_STAGE_A(PG8_SA(0, 0), cAb0, p00, p01); PG8_STAGE_A(PG8_SA(0, 1), cAb1, p10, p11);
    if (wr == 1) PG8_BAR;
    PG8_WAIT_V(2); PG8_BAR;
    PG8_STAGE1(PG8_SB(1, 0), cB + kstep, voffB0); PG8_STAGE_A(PG8_SA(1, 0), cAb0 + kstep, p00, p01); PG8_STAGE1(PG8_SB(1, 1), cB + hstep + kstep, voffB0);
    PG8_WAIT_V(6); PG8_BAR; }
    for (;;) {
        const bool has_next = S.next(ui + 1, nxt);
        if (has_next) { PG8_ADESC(nxt, nAb0, nAb1, sc ^ 1); } else { nAb0 = cAb0; nAb1 = cAb1; }
        const int nbank = has_next ? (sc ^ 1) : sc;
        const char* nB = has_next ? (const char*)Btp + (size_t)nxt.pn * tstep : cB;
        for (int t = 0; t < nt; t += 2) {
            const bool last = (t == nt - 2);
            const int xb = last ? nbank : sc;
            const char* a1h1 = cAb1 + (size_t)(t + 1) * kstep;
            const char* a2h0 = last ? nAb0 : cAb0 + (size_t)(t + 2) * kstep; const char* a2h1 = last ? nAb1 : cAb1 + (size_t)(t + 2) * kstep;
            const char* b2 = last ? nB : cB + (size_t)(t + 2) * kstep;
            const char* a3h0 = a2h0 + kstep; const char* b3 = b2 + kstep;
            { PG8_AOFF(1, sc, q0, q1); PG8_LDB(B0, 0, 0); PG8_LDB(B1, 0, 1); PG8_SCHED; PG8_LDA(At, 0, 0); PG8_STAGE_A(PG8_SA(1, 1), a1h1, q0, q1); }
            PG8_WAIT_V(8); PG8_WAIT_L(0); PG8_BAR; PG8_MMA(0, 0, At, B0); PG8_MMA(0, 1, At, B1); PG8_BAR; PG8_SCHED;
            { PG8_AOFF(0, xb, q0, q1); PG8_LDA(At, 0, 1); PG8_STAGE1(PG8_SB(0, 0), b2, voffB0); PG8_STAGE1(PG8_SB(0, 1), b2 + hstep, voffB0); PG8_STAGE_A(PG8_SA(0, 0), a2h0, q0, q1); }
            PG8_WAIT_V(8); PG8_WAIT_L(0); PG8_BAR; PG8_MMA(1, 0, At, B0); PG8_MMA(1, 1, At, B1); PG8_BAR; PG8_SCHED;
            { PG8_AOFF(1, xb, q0, q1); PG8_LDB(B0, 1, 0); PG8_LDB(B1, 1, 1); PG8_SCHED; PG8_LDA(At, 1, 0); PG8_STAGE_A(PG8_SA(0, 1), a2h1, q0, q1); }
            PG8_WAIT_V(8); PG8_WAIT_L(0); PG8_BAR; PG8_MMA(0, 0, At, B0); PG8_MMA(0, 1, At, B1); PG8_BAR; PG8_SCHED;
            { PG8_AOFF(0, xb, q0, q1); PG8_LDA(At, 1, 1); PG8_STAGE1(PG8_SB(1, 0), b3, voffB0); PG8_STAGE1(PG8_SB(1, 1), b3 + hstep, voffB0); PG8_STAGE_A(PG8_SA(1, 0), a3h0, q0, q1); }
            PG8_WAIT_V(8); PG8_WAIT_L(0); PG8_BAR; PG8_MMA(1, 0, At, B0); PG8_MMA(1, 1, At, B1); PG8_BAR; PG8_SCHED;
        }
        if (wr == 0) PG8_BAR;
        { const int l2_ = lane_id(); E(acc, cur, wr, wc, l2_ & 15, l2_ >> 4);
#ifdef EPI_DUP
          if (Epi::DUPOK) { asm volatile("" ::: "memory"); E(acc, cur, wr, wc, l2_ & 15, l2_ >> 4); }
#endif
        }
        if (!has_next) break;
#pragma unroll
        for (int a = 0; a < 2; ++a)
#pragma unroll
            for (int b = 0; b < 2; ++b)
#pragma unroll
                for (int m = 0; m < 4; ++m)
#pragma unroll
                    for (int n = 0; n < 2; ++n) acc[a][b][m][n] = (f32x4){0.f, 0.f, 0.f, 0.f};
        cur = nxt; cAb0 = nAb0; cAb1 = nAb1; cB = nB; ++ui; sc ^= 1;
        if (wr == 1) PG8_BAR;
    }
    PG8_WAIT_V(0);
    PG8_BAR;
#undef PG8_ADESC
#undef PG8_AOFF
#undef PG8_STASH
#undef PG8_SA
#undef PG8_SB
#undef PG8_STAGE
#undef PG8_STAGE1
#undef PG8_STAGE_A
#undef PG8_LDA
#undef PG8_LDB
#undef PG8_MMA
#undef PG8_WAIT_V
#undef PG8_WAIT_L
#undef PG8_BAR
#undef PG8_SCHED
}
}
using pg8::Unit;

#define XB_TMO      128
#define XB_XCNT(j)  (256  + 64 * (j))
#define XB_XSUB(j)  (1280 + 64 * (j))
#define XB_XGEN(j)  (2304 + 64 * (j))
#define XB_TOP      3328
#define XB_TOPGEN   3392
#define XCD_BAR_WORDS 3456
#define XB_SPIN_CAP (1u << 18)

__device__ __forceinline__ unsigned xb_ld(unsigned* p)              { return __hip_atomic_load(p, __ATOMIC_RELAXED, __HIP_MEMORY_SCOPE_AGENT); }
__device__ __forceinline__ unsigned xb_add(unsigned* p, unsigned v) { return __hip_atomic_fetch_add(p, v, __ATOMIC_RELAXED, __HIP_MEMORY_SCOPE_AGENT); }
__device__ __forceinline__ unsigned xb_xcc_id() { return (unsigned)__builtin_amdgcn_s_getreg((3 << 11) | 20) & 0xFu; }
#define XB_SPIN(cond, bar) do { unsigned _sp = 0; while (cond) { __builtin_amdgcn_s_sleep(1); \
    if ((++_sp & 255u) == 0u) { if (xb_ld(&(bar)[XB_TMO])) break; if (_sp > XB_SPIN_CAP) { atomicAdd(&(bar)[XB_TMO], 1u); break; } } } } while (0)

struct XcdBarrier { unsigned* bar; unsigned x; volatile LAS unsigned* st; };

__device__ __forceinline__ XcdBarrier xcd_barrier_post(const int WID_, unsigned* bar, volatile LAS unsigned* st) {
    XcdBarrier b; b.bar = bar; b.x = xb_xcc_id(); b.st = st;
    if (TIDX == 0) (void)xb_add(&bar[XB_XCNT(b.x)], 1u);
    return b;
}
__device__ __forceinline__ void xcd_barrier_complete(unsigned* bar, unsigned x, unsigned& nloc, unsigned& nx) {
    const unsigned G = gridDim.x * gridDim.y * gridDim.z;
    unsigned sum, cnt, mine, sp = 0u;
    for (;;) {
        sum = 0u; cnt = 0u; mine = 0u;
#pragma unroll
        for (unsigned j = 0; j < 16; ++j) { const unsigned c = xb_ld(&bar[XB_XCNT(j)]); sum += c; cnt += (c > 0u) ? 1u : 0u; mine = (j == x) ? c : mine; }
        if (sum == G) break;
        __builtin_amdgcn_s_sleep(1);
        if ((++sp & 255u) == 0u) { if (xb_ld(&bar[XB_TMO])) break; if (sp > XB_SPIN_CAP) { atomicAdd(&bar[XB_TMO], 1u); break; } }
    }
    nloc = mine > 0u ? mine : 1u; nx = cnt > 0u ? cnt : 1u;
}
__device__ __forceinline__ void xcd_barrier(const int WID_, const XcdBarrier& b) {
    asm volatile("s_waitcnt vmcnt(0)" ::: "memory");
    __syncthreads();
    if (TIDX == 0) {
        unsigned* bar = b.bar;
        __builtin_amdgcn_s_waitcnt(0);
        unsigned nloc = b.st[0], nx = b.st[1];
        if (nloc == 0u) { xcd_barrier_complete(bar, b.x, nloc, nx); b.st[0] = nloc; b.st[1] = nx; }
        const unsigned old = xb_add(&bar[XB_XSUB(b.x)], 1u);
        const unsigned gen = old / nloc;
        if (old + 1u == (gen + 1u) * nloc) {
            __builtin_amdgcn_fence(__ATOMIC_RELEASE, "agent");
            asm volatile("s_waitcnt vmcnt(0)" ::: "memory");
            const unsigned og = xb_add(&bar[XB_TOP], 1u);
            const unsigned tg = og / nx;
            if (og + 1u == (tg + 1u) * nx) xb_add(&bar[XB_TOPGEN], 1u);
            else XB_SPIN(xb_ld(&bar[XB_TOPGEN]) == tg, bar);
            __builtin_amdgcn_fence(__ATOMIC_ACQUIRE, "agent");
            xb_add(&bar[XB_XGEN(b.x)], 1u);
            asm volatile("s_waitcnt vmcnt(0)" ::: "memory");
        } else {
            XB_SPIN(xb_ld(&bar[XB_XGEN(b.x)]) == gen, bar);
            __builtin_amdgcn_fence(__ATOMIC_ACQUIRE, "agent");
            asm volatile("s_waitcnt vmcnt(0)" ::: "memory");
        }
    }
    __syncthreads();
}

struct Params {
    const float* x; const int* positions; const float* attn_norm_w; const float* w_in; const float* gate_bias; const float* w_ret_out; const float* w_swa_out; const float* w_o;
    const float* sinks; const float* ffn_norm_w; const float* router_w; const float* router_b; const float* w_gate_up; const float* b_gate_up; const float* w_down; const float* b_down;
    const float* final_norm_w; float* out; unsigned char* ws; int ph_lo, ph_hi;
};

struct StaticOrder {
    static constexpr bool GATHER = false;
    int nM, nN, G, c;
    __device__ __forceinline__ bool next(int i, Unit& u) const { return pg8::tile_order(i * G + c, nM, nN, u.pm, u.pn); }
    __device__ __forceinline__ int row_token(const Unit&, int) const { return 0; }
};
struct MixOrder {
    static constexpr bool GATHER = false;
    int G, c;
    __device__ __forceinline__ bool next(int i, Unit& u) const { int pm, pn; if (!pg8::tile_order((i >> 1) * G + c, 64, 8, pm, pn)) return false; const int br = i & 1; u.pm = br * 64 + pm; u.pn = br * 8 + pn; return true; }
    __device__ __forceinline__ int row_token(const Unit&, int) const { return 0; }
};
template <bool GATH> struct MoeOrder {
    static constexpr bool GATHER = GATH;
    int T, nN, G, c; const LAS int* cnt; const LAS int* tile0; const LAS int* mte; const int* list;
    __device__ __forceinline__ bool next(int i, Unit& u) const { int pm, pn; if (!pg8::tile_order(i * G + c, T, nN, pm, pn)) return false; const int e = __builtin_amdgcn_readfirstlane(mte[pm]); u.pm = pm; u.pn = e * nN + pn; return true; }
    __device__ __forceinline__ int row_token(const Unit& u, int row) const {
        const int e = u.pn / nN; const int t0 = __builtin_amdgcn_readfirstlane(tile0[e]), ce = __builtin_amdgcn_readfirstlane(cnt[e]);
        int rank = (u.pm - t0) * 256 + row; rank = rank < ce ? rank : ce - 1; return list[e * NTOK + rank]; }
};

struct EpiProj {
    static constexpr bool PERM = true, DUPOK = true;
    unsigned char* ws; const float* gate_bias;
    __device__ __forceinline__ void operator()(const f32x4 (&acc)[2][2][4][2], const Unit& u, int wr, int wc, int fr, int fq) const {
        const int ct = u.pn; const int row0 = u.pm * 256 + wr * 64 + fr; const int cw = wc * 32 + 8 * fq;
        if (ct < 8) {
            bf16_t* dst = (bf16_t*)(ws + (ct < 4 ? WS_RQ : WS_RK)); const int colt = (ct & 3) * 256; const float sc = ct < 4 ? 1.0f : 0.08838834764831845f; const int f0 = 16 * wc + 4 * fq;
            const float* cosr = (const float*)(ws + WS_COSR); const float* sinr = (const float*)(ws + WS_SINR);
#pragma unroll
            for (int ai = 0; ai < 2; ++ai)
#pragma unroll
                for (int m = 0; m < 4; ++m) { const int row = row0 + ai * 128 + m * 16;
                    const f32x4 c = *(const f32x4*)(cosr + (size_t)row * 64 + f0) * sc, s = *(const f32x4*)(sinr + (size_t)row * 64 + f0) * sc;
#pragma unroll
                    for (int bj = 0; bj < 2; ++bj) { const f32x4 v0 = acc[ai][bj][m][0], v1 = acc[ai][bj][m][1]; const f32x4 o1 = v0 * c - v1 * s, o2 = v1 * c + v0 * s;
                        u32x4 w; w.x = cvt_pk(o1[0], o1[1]); w.y = cvt_pk(o1[2], o1[3]); w.z = cvt_pk(o2[0], o2[1]); w.w = cvt_pk(o2[2], o2[3]);
                        *(u32x4*)(dst + (size_t)row * 1024 + colt + bj * 128 + cw) = w; } }
        } else if ((ct >= 24 && ct < 33)) {
            bf16_t* dst = (bf16_t*)(ws + (ct < 32 ? WS_SQ : WS_SK)); const float* coss = (const float*)(ws + WS_COSS); const float* sins = (const float*)(ws + WS_SINS); const int ldc = ct < 32 ? 2048 : 256; const int colt = ct < 32 ? (ct - 24) * 256 : 0; const float sc = ct < 32 ? C2 : 1.0f; const int f0 = 16 * (wc & 1) + 4 * fq;
#pragma unroll
            for (int ai = 0; ai < 2; ++ai)
#pragma unroll
                for (int m = 0; m < 4; ++m) { const int row = row0 + ai * 128 + m * 16;
                    const f32x4 c = *(const f32x4*)(coss + (size_t)row * 32 + f0) * sc, s = *(const f32x4*)(sins + (size_t)row * 32 + f0) * sc;
#pragma unroll
                    for (int bj = 0; bj < 2; ++bj) { const f32x4 v0 = acc[ai][bj][m][0], v1 = acc[ai][bj][m][1]; const f32x4 o1 = v0 * c - v1 * s, o2 = v1 * c + v0 * s;
                        u32x4 w; w.x = cvt_pk(o1[0], o1[1]); w.y = cvt_pk(o1[2], o1[3]); w.z = cvt_pk(o2[0], o2[1]); w.w = cvt_pk(o2[2], o2[3]);
                        *(u32x4*)(dst + (size_t)row * ldc + colt + bj * 128 + cw) = w; } }
        } else if (ct >= 34) {
            const int colt = (ct - 34) * 256; bf16_t* gates = (bf16_t*)(ws + WS_GATES);
            f32x4 b0[2], b1[2];
#pragma unroll
            for (int bj = 0; bj < 2; ++bj) { b0[bj] = *(const f32x4*)(gate_bias + colt + bj * 128 + cw); b1[bj] = *(const f32x4*)(gate_bias + colt + bj * 128 + cw + 4); }
#pragma unroll
            for (int ai = 0; ai < 2; ++ai)
#pragma unroll
                for (int m = 0; m < 4; ++m) { const int row = row0 + ai * 128 + m * 16;
#pragma unroll
                    for (int bj = 0; bj < 2; ++bj) { const f32x4 v0 = acc[ai][bj][m][0] + b0[bj], v1 = acc[ai][bj][m][1] + b1[bj];
                        u32x4 w; w.x = cvt_pk(fast_sigmoid(v0[0]), fast_sigmoid(v0[1])); w.y = cvt_pk(fast_sigmoid(v0[2]), fast_sigmoid(v0[3]));
                        w.z = cvt_pk(fast_sigmoid(v1[0]), fast_sigmoid(v1[1])); w.w = cvt_pk(fast_sigmoid(v1[2]), fast_sigmoid(v1[3]));
                        *(u32x4*)(gates + (size_t)row * 4096 + colt + bj * 128 + cw) = w; } }
        } else {
            const bool act = (ct >= 16 && ct < 24);
            bf16_t* dst = (bf16_t*)(ws + (ct < 16 ? WS_RV : (ct < 24 ? WS_RG : WS_SV))); const int ldc = ct == 33 ? 256 : 2048; const int colt = ct < 16 ? (ct - 8) * 256 : (ct < 24 ? (ct - 16) * 256 : 0);
#pragma unroll
            for (int ai = 0; ai < 2; ++ai)
#pragma unroll
                for (int m = 0; m < 4; ++m) { const int row = row0 + ai * 128 + m * 16;
#pragma unroll
                    for (int bj = 0; bj < 2; ++bj) { f32x4 v0 = acc[ai][bj][m][0], v1 = acc[ai][bj][m][1];
                        if (act) {
#pragma unroll
                            for (int j = 0; j < 4; ++j) { v0[j] = v0[j] * fast_sigmoid(v0[j]); v1[j] = v1[j] * fast_sigmoid(v1[j]); } }
                        u32x4 w; w.x = cvt_pk(v0[0], v0[1]); w.y = cvt_pk(v0[2], v0[3]); w.z = cvt_pk(v1[0], v1[1]); w.w = cvt_pk(v1[2], v1[3]);
                        *(u32x4*)(dst + (size_t)row * ldc + colt + bj * 128 + cw) = w; } }
        }
    }
};
struct EpiMix {
    static constexpr bool PERM = true, DUPOK = false;
    const bf16_t* gates; bf16_t* mix;
    __device__ __forceinline__ void operator()(const f32x4 (&acc)[2][2][4][2], const Unit& u, int wr, int wc, int fr, int fq) const {
        const int br = u.pm >> 6, pm = u.pm & 63, ct = u.pn & 7; const int row0 = pm * 256 + wr * 64 + fr; const int col0 = ct * 256 + wc * 32 + 8 * fq;
#pragma unroll
        for (int ai = 0; ai < 2; ++ai)
#pragma unroll
            for (int m = 0; m < 4; ++m) { const int row = row0 + ai * 128 + m * 16;
#pragma unroll
                for (int bj = 0; bj < 2; ++bj) { const int col = col0 + bj * 128;
                    const u32x4 g = *(const u32x4*)(gates + (size_t)row * 4096 + br * 2048 + col);
                    f32x4 v0 = acc[ai][bj][m][0], v1 = acc[ai][bj][m][1];
                    v0[0] *= bf_lo(g.x); v0[1] *= bf_hi(g.x); v0[2] *= bf_lo(g.y); v0[3] *= bf_hi(g.y); v1[0] *= bf_lo(g.z); v1[1] *= bf_hi(g.z); v1[2] *= bf_lo(g.w); v1[3] *= bf_hi(g.w);
                    bf16_t* dp = mix + (size_t)row * 2048 + col;
                    if (br) { const u32x4 t = *(const u32x4*)dp;
                        v0[0] += bf_lo(t.x); v0[1] += bf_hi(t.x); v0[2] += bf_lo(t.y); v0[3] += bf_hi(t.y); v1[0] += bf_lo(t.z); v1[1] += bf_hi(t.z); v1[2] += bf_lo(t.w); v1[3] += bf_hi(t.w); }
                    u32x4 w; w.x = cvt_pk(v0[0], v0[1]); w.y = cvt_pk(v0[2], v0[3]); w.z = cvt_pk(v1[0], v1[1]); w.w = cvt_pk(v1[2], v1[3]);
                    *(u32x4*)dp = w; } }
    }
};
struct EpiResid {
    static constexpr bool PERM = false, DUPOK = false;
    const float* x; float* h2;
    __device__ __forceinline__ void operator()(const f32x4 (&acc)[2][2][4][2], const Unit& u, int wr, int wc, int fr, int fq) const {
        const int row0 = u.pm * 256 + wr * 64 + fr, col0 = u.pn * 256 + wc * 32 + 4 * fq;
#pragma unroll
        for (int ai = 0; ai < 2; ++ai)
#pragma unroll
            for (int m = 0; m < 4; ++m) { const size_t off = (size_t)(row0 + ai * 128 + m * 16) * 2048 + col0;
#pragma unroll
                for (int bj = 0; bj < 2; ++bj)
#pragma unroll
                    for (int n = 0; n < 2; ++n) { const f32x4 xv = *(const f32x4*)(x + off + bj * 128 + n * 16); *(f32x4*)(h2 + off + bj * 128 + n * 16) = xv + acc[ai][bj][m][n]; } }
    }
};
struct EpiSwiglu {
    static constexpr bool PERM = true, DUPOK = false;
    const float* b_gate_up; bf16_t* act;
    __device__ __forceinline__ void operator()(const f32x4 (&acc)[2][2][4][2], const Unit& u, int wr, int wc, int fr, int fq) const {
        const int e = u.pn >> 4, ct = u.pn & 15; const int row0 = u.pm * 256 + wr * 64 + fr; const int col0 = ct * 256 + wc * 32 + 8 * fq;
        f32x4 b0[2], b1[2];
#pragma unroll
        for (int bj = 0; bj < 2; ++bj) { b0[bj] = *(const f32x4*)(b_gate_up + (size_t)e * 4096 + col0 + bj * 128); b1[bj] = *(const f32x4*)(b_gate_up + (size_t)e * 4096 + col0 + bj * 128 + 4); }
#pragma unroll
        for (int ai = 0; ai < 2; ++ai)
#pragma unroll
            for (int m = 0; m < 4; ++m) { const int row = row0 + ai * 128 + m * 16;
#pragma unroll
                for (int bj = 0; bj < 2; ++bj) { const f32x4 v0 = acc[ai][bj][m][0] * (1.0f / (SC_W * SC_X)) + b0[bj], v1 = acc[ai][bj][m][1] * (1.0f / (SC_W * SC_X)) + b1[bj];
                    float a[4];
#pragma unroll
                    for (int j = 0; j < 4; ++j) { const float gt = fminf(j < 2 ? v0[2 * j] : v1[2 * j - 4], 7.0f); const float ln = fminf(fmaxf(j < 2 ? v0[2 * j + 1] : v1[2 * j - 3], -7.0f), 7.0f);
                        a[j] = gt * fast_sigmoid(1.702f * gt) * (ln + 1.0f); }
                    if constexpr (MOE_FP8 != 0) { *(unsigned*)((unsigned char*)act + (size_t)row * 2048 + ((col0 + bj * 128) >> 1)) = pk_fp8x4(a[0] * SC_ACT, a[1] * SC_ACT, a[2] * SC_ACT, a[3] * SC_ACT); }
                    else { u32x2 w; w.x = cvt_pk(a[0], a[1]); w.y = cvt_pk(a[2], a[3]); *(u32x2*)(act + (size_t)row * 2048 + ((col0 + bj * 128) >> 1)) = w; } } }
    }
};
struct EpiDown {
    static constexpr bool PERM = true, DUPOK = false;
    const float* b_down; bf16_t* y;
    __device__ __forceinline__ void operator()(const f32x4 (&acc)[2][2][4][2], const Unit& u, int wr, int wc, int fr, int fq) const {
        const int e = u.pn >> 3, ct = u.pn & 7; const int row0 = u.pm * 256 + wr * 64 + fr; const int col0 = ct * 256 + wc * 32 + 8 * fq;
        f32x4 b0[2], b1[2];
#pragma unroll
        for (int bj = 0; bj < 2; ++bj) { b0[bj] = *(const f32x4*)(b_down + (size_t)e * 2048 + col0 + bj * 128); b1[bj] = *(const f32x4*)(b_down + (size_t)e * 2048 + col0 + bj * 128 + 4); }
#pragma unroll
        for (int ai = 0; ai < 2; ++ai)
#pragma unroll
            for (int m = 0; m < 4; ++m) { const int row = row0 + ai * 128 + m * 16;
#pragma unroll
                for (int bj = 0; bj < 2; ++bj) { const f32x4 v0 = acc[ai][bj][m][0] * (1.0f / (SC_W * SC_ACT)) + b0[bj], v1 = acc[ai][bj][m][1] * (1.0f / (SC_W * SC_ACT)) + b1[bj];
                    u32x4 w; w.x = cvt_pk(v0[0], v0[1]); w.y = cvt_pk(v0[2], v0[3]); w.z = cvt_pk(v1[0], v1[1]); w.w = cvt_pk(v1[2], v1[3]);
                    *(u32x4*)(y + (size_t)row * 2048 + col0 + bj * 128) = w; } }
    }
};

__device__ __forceinline__ float wave_sum(float v) {
#pragma unroll
    for (int o = 1; o < 64; o <<= 1) v += __shfl_xor(v, o);
    return v;
}
__device__ __forceinline__ int win_src_col4(int n) {
    if (n < 2048) { const int p = n & 127; return (n & ~127) + ((p >> 2) & 1) * 64 + 4 * (p >> 3); }
    if (n >= 6144 && n < 8448) { const int p = n & 63; return (n & ~63) + ((p >> 2) & 1) * 32 + 4 * (p >> 3); }
    return n;
}
struct P0Tile { const float* W; unsigned char* WT; int N, K, k0, n0, kind, perm; };
__device__ __forceinline__ void p0_decode(const Params& p, int it, P0Tile& t) {
    constexpr int T_IN = 32 * 200, T_SQ = 32 * 32, T_GU = 32 * 32 * 64;
    unsigned char* ws = p.ws; int r = it;
    if (r < T_IN) { t.W = p.w_in; t.WT = ws + WS_WIN_T; t.N = INW; t.K = DM; t.k0 = (r / 200) * 64; t.n0 = (r % 200) * 64; t.kind = 0; t.perm = 1; return; } r -= T_IN;
    if (r < 3 * T_SQ) { const int w = r / T_SQ; r -= w * T_SQ; t.W = w == 0 ? p.w_ret_out : (w == 1 ? p.w_swa_out : p.w_o); t.WT = w == 2 ? ws + WS_WO_T : ws + WS_WBR_T + (size_t)w * DM * DM * 2;
        t.N = DM; t.K = DM; t.k0 = (r / 32) * 64; t.n0 = (r % 32) * 64; t.kind = 0; t.perm = 0; return; } r -= 3 * T_SQ;
    if (r < T_GU) { const int e = r / 2048; r -= e * 2048; t.W = p.w_gate_up + (size_t)e * DM * 4096; t.WT = ws + WS_WGU_T + (size_t)e * 4096 * DM * MOE_EB; t.N = 4096; t.K = DM; if (MOE_FP8) { t.k0 = (r / 128) * 128; t.n0 = (r % 128) * 32; } else { t.k0 = (r / 64) * 64; t.n0 = (r % 64) * 64; } t.kind = MOE_FP8 ? 1 : 0; t.perm = 0; return; } r -= T_GU;
    { const int e = r / 1024; r -= e * 1024; t.W = p.w_down + (size_t)e * DFF * DM; t.WT = ws + WS_WDN_T + (size_t)e * DM * DFF * MOE_EB; t.N = DM; t.K = DFF; if (MOE_FP8) { t.k0 = (r / 64) * 128; t.n0 = (r % 64) * 32; } else { t.k0 = (r / 32) * 64; t.n0 = (r % 32) * 64; } t.kind = MOE_FP8 ? 1 : 0; t.perm = 0; }
}
__device__ __forceinline__ void p0_load(const P0Tile& t, f32x4 (&v)[16], int lane) {
    if (t.kind == 1) {
        const float* src = t.W + (size_t)(t.k0 + (lane >> 3)) * t.N + t.n0 + 4 * (lane & 7);
#pragma unroll
        for (int i = 0; i < 16; ++i) v[i] = __builtin_nontemporal_load((const f32x4*)(src + (size_t)(8 * i) * t.N));
    } else {
        const int n4 = t.n0 + 4 * (lane & 15); const int srccol = t.perm ? win_src_col4(n4) : n4;
        const float* src = t.W + (size_t)(t.k0 + (lane >> 4)) * t.N + srccol;
#pragma unroll
        for (int i = 0; i < 16; ++i) v[i] = __builtin_nontemporal_load((const f32x4*)(src + (size_t)(4 * i) * t.N));
    }
}
__device__ __forceinline__ void p0_prologue(const int WID_, const Params& p, LAS unsigned char* lds, int vcu, int G) {
    const int tid = TIDX, lane = tid & 63, wave = WID_;
    LAS float* scr = (LAS float*)(lds + wave * 16896);
    const int gw = vcu * 8 + wave, NGW = G * 8;
    unsigned char* ws = p.ws;
    constexpr int NT_ALL = 32 * 200 + 3 * 32 * 32 + 32 * 32 * 64 + 32 * 32 * 32;
#ifndef P0_DUP_PART
#define P0_DUP_PART 0
#endif
    for (int rp_ = 0; rp_ < (P0_DUP_PART == 1 ? 2 : 1); ++rp_) {
        int it = gw; P0Tile t, tn; f32x4 v[16];
        if (it < NT_ALL) { p0_decode(p, it, t); p0_load(t, v, lane); }
        while (it < NT_ALL) {
            if (t.kind == 1) {
#pragma unroll
                for (int i = 0; i < 16; ++i) { LAS float* d = scr + ((lane >> 3) + 8 * i) * 33 + 4 * (lane & 7); d[0] = v[i][0]; d[1] = v[i][1]; d[2] = v[i][2]; d[3] = v[i][3]; }
            } else {
#pragma unroll
                for (int i = 0; i < 16; ++i) { LAS float* d = scr + ((lane >> 4) + 4 * i) * 65 + 4 * (lane & 15); d[0] = v[i][0]; d[1] = v[i][1]; d[2] = v[i][2]; d[3] = v[i][3]; }
            }
            const int nit = it + NGW;
            if (nit < NT_ALL) { p0_decode(p, nit, tn); p0_load(tn, v, lane); }
            asm volatile("s_waitcnt lgkmcnt(0)" ::: "memory");
            if (t.kind == 0) { const int c = lane & 7; bf16_t* WT = (bf16_t*)t.WT;
#pragma unroll
                for (int j = 0; j < 8; ++j) { const int n = (lane >> 3) + 8 * j; const LAS float* s = scr + (8 * c) * 65 + n;
                    u32x4 o; o.x = cvt_pk(s[0], s[65]); o.y = cvt_pk(s[2 * 65], s[3 * 65]); o.z = cvt_pk(s[4 * 65], s[5 * 65]); o.w = cvt_pk(s[6 * 65], s[7 * 65]);
                    *(u32x4*)(WT + (size_t)(t.n0 + n) * t.K + t.k0 + 8 * c) = o; }
            } else { const int c = lane & 7;
#pragma unroll
                for (int j = 0; j < 4; ++j) { const int n = (lane >> 3) + 8 * j; const LAS float* s = scr + (16 * c) * 33 + n;
                    u32x4 o; o.x = pk_fp8x4(s[0] * SC_W, s[33] * SC_W, s[2 * 33] * SC_W, s[3 * 33] * SC_W); o.y = pk_fp8x4(s[4 * 33] * SC_W, s[5 * 33] * SC_W, s[6 * 33] * SC_W, s[7 * 33] * SC_W);
                    o.z = pk_fp8x4(s[8 * 33] * SC_W, s[9 * 33] * SC_W, s[10 * 33] * SC_W, s[11 * 33] * SC_W); o.w = pk_fp8x4(s[12 * 33] * SC_W, s[13 * 33] * SC_W, s[14 * 33] * SC_W, s[15 * 33] * SC_W);
                    *(u32x4*)(t.WT + (size_t)(t.n0 + n) * t.K + t.k0 + 16 * c) = o; }
            }
            asm volatile("s_waitcnt lgkmcnt(0)" ::: "memory");
            it = nit; t = tn;
        }
    }
    for (int rp_ = 0; rp_ < (P0_DUP_PART == 2 ? 2 : 1); ++rp_)
    for (int m = gw; m < NTOK; m += NGW) {
        const f32x4* xr = (const f32x4*)(p.x + (size_t)m * DM) + lane; const f32x4* wr = (const f32x4*)p.attn_norm_w + lane;
        f32x4 v[8]; float s = 0.f;
#pragma unroll
        for (int j = 0; j < 8; ++j) { v[j] = xr[64 * j]; s += (v[j][0] * v[j][0] + v[j][1] * v[j][1]) + (v[j][2] * v[j][2] + v[j][3] * v[j][3]); }
        const float rs = rsqrtf(wave_sum(s) * (1.0f / DM) + RMS_EPS);
        u32x2* o8 = (u32x2*)((bf16_t*)(ws + WS_XN) + (size_t)m * DM) + lane;
#pragma unroll
        for (int j = 0; j < 8; ++j) { const f32x4 w = wr[64 * j]; u32x2 o; o.x = cvt_pk(v[j][0] * rs * w[0], v[j][1] * rs * w[1]); o.y = cvt_pk(v[j][2] * rs * w[2], v[j][3] * rs * w[3]); o8[64 * j] = o; }
    }
    const int gt = (vcu * 512 + tid), NGT = G * 512;
    for (int rp_ = 0; rp_ < (P0_DUP_PART == 3 ? 2 : 1); ++rp_)
    for (int i = gt; i < NTOK * 96; i += NGT) {
        const int tok = i / 96, f = i % 96; const float pos = (float)p.positions[tok];
        float inv; if (f < 64) inv = expf(-9.210340371976184f * (float)(2 * f) * (1.0f / 128.0f)); else inv = expf(-9.210340371976184f * (float)(2 * (f - 64)) * (1.0f / 64.0f));
        const float ang = pos * inv; const float sn = __sinf(ang), cs = __cosf(ang);
        if (f < 64) { ((float*)(ws + WS_COSR))[(size_t)tok * 64 + f] = cs; ((float*)(ws + WS_SINR))[(size_t)tok * 64 + f] = sn; }
        else { ((float*)(ws + WS_COSS))[(size_t)tok * 32 + f - 64] = cs; ((float*)(ws + WS_SINS))[(size_t)tok * 32 + f - 64] = sn; }
    }
}

__device__ __forceinline__ float ret_l2g(int h) { return log1pf(-exp2f(-5.0f - (float)h)) * LOG2E; }

__device__ __forceinline__ void ret_u_phase(const int WID_, LAS unsigned char* lds, const bf16_t* RK, const bf16_t* RV, float* UT, int vcu, int G) {
    constexpr int NU = NB * 31 * 8;
    int it = vcu; if (it >= NU) return;
    const int tid = TIDX, lane = tid & 63, r32 = lane & 31, hi = lane >> 5; const int wid = WID_;
    u32x4 kreg[4], vreg[8];
#define RU_LOAD(itx) do { const int h_ = (itx) & 7, n_ = ((itx) >> 3) % 31, b_ = (itx) / 248; const size_t t0_ = (size_t)b_ * SEQ + (size_t)n_ * 128; \
        _Pragma("unroll") for (int i = 0; i < 4; ++i) { const int x = tid + 512 * i, ch = x & 15, row = x >> 4; kreg[i] = *(const u32x4*)(RK + (t0_ + row) * 1024 + h_ * 128 + ch * 8); } \
        _Pragma("unroll") for (int i = 0; i < 8; ++i) { const int x = tid + 512 * i, ch = x & 31, row = x >> 5; vreg[i] = *(const u32x4*)(RV + (t0_ + row) * 2048 + h_ * 256 + ch * 8); } } while (0)
    RU_LOAD(it);
    const int trb = (8 * hi + ((lane & 15) >> 2)) * 64 + ((lane >> 4) & 1) * 32 + (lane & 3) * 8;
    for (;;) {
        const int h = it & 7, n = (it >> 3) % 31, b = it / 248;
        const float l2g = ret_l2g(h);
#pragma unroll
        for (int i = 0; i < 4; ++i) { const int x = tid + 512 * i, ch = x & 15, row = x >> 4; *(LAS u32x4*)(lds + (ch >> 2) * 8192 + row * 64 + (ch & 3) * 16) = kreg[i]; }
#pragma unroll
        for (int i = 0; i < 8; ++i) { const int x = tid + 512 * i, ch = x & 31, row = x >> 5; u32x4 v = vreg[i];
            const float z = exp2f(l2g * (float)(127 - row));
            v.x = cvt_pk(bf_lo(v.x) * z, bf_hi(v.x) * z); v.y = cvt_pk(bf_lo(v.y) * z, bf_hi(v.y) * z); v.z = cvt_pk(bf_lo(v.z) * z, bf_hi(v.z) * z); v.w = cvt_pk(bf_lo(v.w) * z, bf_hi(v.w) * z);
            *(LAS u32x4*)(lds + 32768 + (ch >> 2) * 8192 + row * 64 + (ch & 3) * 16) = v; }
        __syncthreads();
        const int itn = it + G; const bool has = itn < NU;
        if (has) RU_LOAD(itn);
        f32x16 acc[4];
#pragma unroll
        for (int c = 0; c < 4; ++c) acc[c] = (f32x16){};
#pragma unroll 2
        for (int ks = 0; ks < 8; ++ks) {
            const LAS unsigned char* vp = lds + 32768 + wid * 8192 + ks * 1024 + trb;
            const bf16x8 vf = mk8(tr16(vp), tr16(vp + 256));
#pragma unroll
            for (int c = 0; c < 4; ++c) { const LAS unsigned char* kp = lds + c * 8192 + ks * 1024 + trb; const bf16x8 kf = mk8(tr16(kp), tr16(kp + 256));
                acc[c] = __builtin_amdgcn_mfma_f32_32x32x16_bf16(kf, vf, acc[c], 0, 0, 0); }
        }
        float* up = UT + ((((size_t)b * 32 + n) * 8 + h) * 8 + wid) * 4096 + r32 * 8 + 4 * hi;
#pragma unroll
        for (int c = 0; c < 4; ++c)
#pragma unroll
            for (int g = 0; g < 4; ++g) *(f32x4*)(up + (((2 * c + (g >> 1)) * 2 + (g & 1)) * 32) * 8) = (f32x4){acc[c][4 * g], acc[c][4 * g + 1], acc[c][4 * g + 2], acc[c][4 * g + 3]};
        if (!has) break;
        __syncthreads();
        it = itn;
    }
#undef RU_LOAD
    __syncthreads();
}

__device__ __forceinline__ void swa_phase(const int WID_, LAS unsigned char* lds, const bf16_t* SQ, const bf16_t* SK, const bf16_t* SV, const float* sinks, bf16_t* SWAO, int vcu, int G) {
    constexpr int NU = NB * 32 * 4;
    int it = vcu; if (it >= NU) return;
    const int wid = WID_;
    u32x4 qn[4];
#define SW_LOAD(itx) do { const int kvh_ = (itx) & 3, n_ = ((itx) >> 2) & 31, b_ = (itx) >> 7; const long band0_ = (long)b_ * SEQ + (long)n_ * 128 - 128; \
        _Pragma("unroll") for (int i = 0; i < 4; ++i) { const int x = tid + 512 * i, ch = x & 7, row = x >> 3; long tk = band0_ + row; if (tk < 0) tk = 0; \
            kreg[i] = *(const u32x4*)(SK + tk * 256 + kvh_ * 64 + ch * 8); vreg[i] = *(const u32x4*)(SV + tk * 256 + kvh_ * 64 + ch * 8); } } while (0)
#define SW_QLOAD(itx, s_) do { const int kvh_ = (itx) & 3, n_ = ((itx) >> 2) & 31, b_ = (itx) >> 7; const size_t tq_ = (size_t)b_ * SEQ + (size_t)n_ * 128 + 32 * (s_); \
        _Pragma("unroll") for (int i = 0; i < 4; ++i) { const int x = lane + 64 * i, row = x >> 3, ch = x & 7; qn[i] = *(const u32x4*)(SQ + (tq_ + row) * 2048 + (kvh_ * 8 + wid) * 64 + ch * 8); } } while (0)
    { const int lane = lane_id(); SW_QLOAD(it, 0); }
    LAS unsigned char* qs = lds + 65536 + wid * 4608;
    for (;;) {
        const int kvh = it & 3, n = (it >> 2) & 31, b = it >> 7;
        const long tokq = (long)b * SEQ + (long)n * 128;
        const int tid = TIDX, lane = tid & 63, r32 = lane & 31, hi = lane >> 5;
        const int trb = (4 * hi + ((lane & 15) >> 2)) * 64 + ((lane >> 4) & 1) * 32 + (lane & 3) * 8;
        u32x4 kreg[4], vreg[4]; SW_LOAD(it);
#pragma unroll
        for (int i = 0; i < 4; ++i) { const int x = tid + 512 * i, ch = x & 7, row = x >> 3;
            *(LAS u32x4*)(lds + ch * 4096 + row * 16) = kreg[i];
            *(LAS u32x4*)(lds + 32768 + (ch >> 2) * 16384 + row * 64 + (ch & 3) * 16) = vreg[i]; }
        __syncthreads();
        const int itn = it + G; const bool has = itn < NU;
        const int qh = kvh * 8 + wid; const float sink2 = sinks[qh] * LOG2E;
#pragma unroll 1
        for (int s = 0; s < 4; ++s) {
            bf16x8 qr[4];
#pragma unroll
            for (int i = 0; i < 4; ++i) { const int x = lane + 64 * i, row = x >> 3, ch = x & 7; *(LAS u32x4*)(qs + row * 144 + ch * 16) = qn[i]; }
            asm volatile("" ::: "memory");
#pragma unroll
            for (int d0 = 0; d0 < 4; ++d0) qr[d0] = *(const LAS bf16x8*)(qs + r32 * 144 + (2 * d0 + hi) * 16);
            asm volatile("" ::: "memory");
            if (s < 3) { SW_QLOAD(it, s + 1); } else if (has) { SW_QLOAD(itn, 0); }
            const int t_lo = s < 2 ? 0 : 1;
            f32x16 pt[3][2];
#pragma unroll
            for (int tt = 0; tt < 3; ++tt)
#pragma unroll
                for (int hf = 0; hf < 2; ++hf) { f32x16 a = (f32x16){};
                    const LAS unsigned char* kp = lds + hi * 4096 + (64 * (t_lo + tt) + 32 * hf + r32) * 16;
#pragma unroll
                    for (int d0 = 0; d0 < 4; ++d0) { const bf16x8 kf = *(const LAS bf16x8*)(kp + d0 * 8192); a = __builtin_amdgcn_mfma_f32_32x32x16_bf16(kf, qr[d0], a, 0, 0, 0); }
                    pt[tt][hf] = a; }
            const int iq = 32 * s + r32; float mx = sink2;
#pragma unroll
            for (int tt = 0; tt < 3; ++tt)
#pragma unroll
                for (int hf = 0; hf < 2; ++hf)
#pragma unroll
                    for (int r = 0; r < 16; ++r) { const int jp = 64 * (t_lo + tt) + 32 * hf + crow(r, hi);
                        const bool valid = (jp > iq) && (jp <= iq + 128) && (n > 0 || jp >= 128);
                        const float v = valid ? pt[tt][hf][r] : -INFINITY; pt[tt][hf][r] = v; mx = fmaxf(mx, v); }
            mx = fmaxf(mx, __shfl_xor(mx, 32));
            float l = 0.f;
#pragma unroll
            for (int tt = 0; tt < 3; ++tt)
#pragma unroll
                for (int hf = 0; hf < 2; ++hf)
#pragma unroll
                    for (int r = 0; r < 16; ++r) { const float e = exp2f(pt[tt][hf][r] - mx); pt[tt][hf][r] = e; l += e; }
            l += __shfl_xor(l, 32); l += exp2f(sink2 - mx);
            const float linv = 1.0f / l;
            f32x16 o[2]; o[0] = (f32x16){}; o[1] = (f32x16){};
#pragma unroll
            for (int tt = 0; tt < 3; ++tt)
#pragma unroll
                for (int hf = 0; hf < 2; ++hf)
#pragma unroll
                    for (int k2 = 0; k2 < 2; ++k2) {
                        u32x4 pw; pw.x = cvt_pk(pt[tt][hf][8 * k2 + 0], pt[tt][hf][8 * k2 + 1]); pw.y = cvt_pk(pt[tt][hf][8 * k2 + 2], pt[tt][hf][8 * k2 + 3]);
                        pw.z = cvt_pk(pt[tt][hf][8 * k2 + 4], pt[tt][hf][8 * k2 + 5]); pw.w = cvt_pk(pt[tt][hf][8 * k2 + 6], pt[tt][hf][8 * k2 + 7]);
                        const bf16x8 pa = __builtin_bit_cast(bf16x8, pw);
                        const int krow = 64 * (t_lo + tt) + 32 * hf + 16 * k2;
#pragma unroll
                        for (int d0 = 0; d0 < 2; ++d0) { const LAS unsigned char* vp = lds + 32768 + d0 * 16384 + krow * 64 + trb; const bf16x8 vf = mk8(tr16(vp), tr16(vp + 512));
                            o[d0] = __builtin_amdgcn_mfma_f32_32x32x16_bf16(pa, vf, o[d0], 0, 0, 0); }
                    }
            { LAS bf16_t* stg = (LAS bf16_t*)qs;
#pragma unroll
              for (int r = 0; r < 16; ++r) { const int q = crow(r, hi); const float li = __shfl(linv, q);
                  stg[q * 72 + r32] = (bf16_t)(cvt_pk(o[0][r] * li, 0.f) & 0xffffu); stg[q * 72 + 32 + r32] = (bf16_t)(cvt_pk(o[1][r] * li, 0.f) & 0xffffu); }
              asm volatile("" ::: "memory");
              bf16_t* op = SWAO + (size_t)(tokq + 32 * s) * 2048 + qh * 64;
#pragma unroll
              for (int i = 0; i < 4; ++i) { const int x = lane + 64 * i, row = x >> 3, ch = x & 7; *(u32x4*)(op + (size_t)row * 2048 + ch * 8) = *(const LAS u32x4*)(stg + row * 72 + ch * 8); }
              asm volatile("" ::: "memory"); }
        }
        if (!has) break;
        __syncthreads();
        it = itn;
    }
#undef SW_LOAD
#undef SW_QLOAD
    __syncthreads();
}

__device__ __forceinline__ void ret_scan(const int WID_, const float* UT, bf16_t* PNT, int vcu, int G) {
    const int gt = vcu * 512 + TIDX, NGT = G * 512;
    for (int idx = gt; idx < NB * 8 * 4096; idx += NGT) {
        const int slot = idx & 4095, h = (idx >> 12) & 7, b = idx >> 15;
        const float dec = exp2f(ret_l2g(h) * 128.0f);
        f32x4 P0 = (f32x4){0.f, 0.f, 0.f, 0.f}, P1 = (f32x4){0.f, 0.f, 0.f, 0.f};
#pragma unroll 8
        for (int n = 0; n < 32; ++n) { const size_t off = ((((size_t)b * 32 + n) * 8 + h) * 4096 + slot) * 8;
            u32x4 o; o.x = cvt_pk(P0[0], P0[1]); o.y = cvt_pk(P0[2], P0[3]); o.z = cvt_pk(P1[0], P1[1]); o.w = cvt_pk(P1[2], P1[3]); *(u32x4*)(PNT + off) = o;
            if (n < 31) { const f32x4 U0 = *(const f32x4*)(UT + off), U1 = *(const f32x4*)(UT + off + 4); P0 = P0 * dec + U0; P1 = P1 * dec + U1; } }
    }
}

__device__ __forceinline__ void ret_out_phase(const int WID_, LAS unsigned char* lds, const bf16_t* RQ, const bf16_t* RK, const bf16_t* RV, const bf16_t* RG, const bf16_t* PNT, bf16_t* RETO, int vcu, int G) {
    constexpr int NU = NB * 32 * 8;
    int it = vcu; if (it >= NU) return;
    const int wid = WID_;
    u32x4 kreg[4], vreg[8], qreg[4];
#define RO_LOAD(itx) do { const int tid_ = TIDX; const int h_ = (itx) & 7, n_ = ((itx) >> 3) & 31, b_ = (itx) >> 8; const size_t t0_ = (size_t)b_ * SEQ + (size_t)n_ * 128; \
        _Pragma("unroll") for (int i = 0; i < 4; ++i) { const int x = tid_ + 512 * i, ch = x & 15, row = x >> 4; kreg[i] = *(const u32x4*)(RK + (t0_ + row) * 1024 + h_ * 128 + ch * 8); qreg[i] = *(const u32x4*)(RQ + (t0_ + row) * 1024 + h_ * 128 + ch * 8); } \
        _Pragma("unroll") for (int i = 0; i < 8; ++i) { const int x = tid_ + 512 * i, ch = x & 31, row = x >> 5; vreg[i] = *(const u32x4*)(RV + (t0_ + row) * 2048 + h_ * 256 + ch * 8); } } while (0)
    RO_LOAD(it);
    for (;;) {
        const int h = it & 7, n = (it >> 3) & 31, b = it >> 8;
        const int tid = TIDX, lane = tid & 63, r32 = lane & 31, hi = lane >> 5;
        const size_t tok0 = (size_t)b * SEQ + (size_t)n * 128;
        const float l2g = ret_l2g(h);
#pragma unroll
        for (int i = 0; i < 4; ++i) { const int x = tid + 512 * i, ch = x & 15, row = x >> 4; *(LAS u32x4*)(lds + ch * 2048 + row * 16) = kreg[i]; *(LAS u32x4*)(lds + 98304 + ch * 2048 + row * 16) = qreg[i]; }
#pragma unroll
        for (int i = 0; i < 8; ++i) { const int x = tid + 512 * i, ch = x & 31, row = x >> 5; *(LAS u32x4*)(lds + 32768 + (ch >> 2) * 8192 + row * 64 + (ch & 3) * 16) = vreg[i]; }
        __syncthreads();
        const int rb = wid & 3, eh = wid >> 2;
        bf16x8 qr[8];
#pragma unroll
        for (int d0 = 0; d0 < 8; ++d0) qr[d0] = *(const LAS bf16x8*)(lds + 98304 + (2 * d0 + hi) * 2048 + (32 * rb + r32) * 16);
        f32x16 o[4];
#pragma unroll
        for (int c = 0; c < 4; ++c) o[c] = (f32x16){};
        if (n > 0) {
            const bf16_t* pp = PNT + ((((size_t)b * 32 + n) * 8 + h) * 8 + 4 * eh) * 4096 + lane * 8;
#pragma unroll
            for (int d0 = 0; d0 < 8; ++d0)
#pragma unroll
                for (int c = 0; c < 4; ++c) { const bf16x8 bfr = *(const bf16x8*)(pp + (size_t)(c * 8 + d0) * 512); o[c] = __builtin_amdgcn_mfma_f32_32x32x16_bf16(qr[d0], bfr, o[c], 0, 0, 0); }
#pragma unroll
            for (int r = 0; r < 16; ++r) { const float xi = exp2f(l2g * (float)(32 * rb + crow(r, hi) + 1));
#pragma unroll
                for (int c = 0; c < 4; ++c) o[c][r] *= xi; }
        }
        const int itn = it + G; const bool has = itn < NU;
        if (has) RO_LOAD(itn);
        const int trb = (4 * hi + ((lane & 15) >> 2)) * 64 + ((lane >> 4) & 1) * 32 + (lane & 3) * 8;
        for (int jb = 0; jb <= rb; ++jb) {
            f32x16 st = (f32x16){};
            const LAS unsigned char* kp = lds + hi * 2048 + (32 * jb + r32) * 16;
#pragma unroll
            for (int d0 = 0; d0 < 8; ++d0) { const bf16x8 kf = *(const LAS bf16x8*)(kp + d0 * 4096); st = __builtin_amdgcn_mfma_f32_32x32x16_bf16(kf, qr[d0], st, 0, 0, 0); }
            const int iq = 32 * rb + r32;
#pragma unroll
            for (int r = 0; r < 16; ++r) { const int j = 32 * jb + crow(r, hi); const int dd = iq - j; st[r] = dd >= 0 ? st[r] * exp2f(l2g * (float)dd) : 0.f; }
#pragma unroll
            for (int k2 = 0; k2 < 2; ++k2) {
                u32x4 pw; pw.x = cvt_pk(st[8 * k2 + 0], st[8 * k2 + 1]); pw.y = cvt_pk(st[8 * k2 + 2], st[8 * k2 + 3]); pw.z = cvt_pk(st[8 * k2 + 4], st[8 * k2 + 5]); pw.w = cvt_pk(st[8 * k2 + 6], st[8 * k2 + 7]);
                const bf16x8 pa = __builtin_bit_cast(bf16x8, pw);
                const int krow = 32 * jb + 16 * k2;
#pragma unroll
                for (int c = 0; c < 4; ++c) { const LAS unsigned char* vp = lds + 32768 + (4 * eh + c) * 8192 + krow * 64 + trb; const bf16x8 vf = mk8(tr16(vp), tr16(vp + 512));
                    o[c] = __builtin_amdgcn_mfma_f32_32x32x16_bf16(pa, vf, o[c], 0, 0, 0); }
            }
        }
        float ss[16];
#pragma unroll
        for (int r = 0; r < 16; ++r) { float a = 0.f;
#pragma unroll
            for (int c = 0; c < 4; ++c) a += o[c][r] * o[c][r];
            a += __shfl_xor(a, 1); a += __shfl_xor(a, 2); a += __shfl_xor(a, 4); a += __shfl_xor(a, 8); a += __shfl_xor(a, 16); ss[r] = a; }
        __syncthreads();
        LAS float* sx = (LAS float*)(lds + 131072);
        if (r32 == 0) {
#pragma unroll
            for (int r = 0; r < 16; ++r) sx[wid * 32 + crow(r, hi)] = ss[r]; }
        __syncthreads();
        { LAS bf16_t* stg = (LAS bf16_t*)(lds + wid * 8704);
#pragma unroll
          for (int r = 0; r < 16; ++r) { const int q = crow(r, hi); const float tot = ss[r] + sx[(wid ^ 4) * 32 + q]; const float rstd = rsqrtf(tot * (1.0f / 256.0f) + RMS_EPS);
#pragma unroll
              for (int c = 0; c < 4; ++c) stg[q * 136 + 32 * c + r32] = (bf16_t)(cvt_pk(o[c][r] * rstd, 0.f) & 0xffffu); }
          asm volatile("" ::: "memory");
          const bf16_t* gp = RG + (tok0 + 32 * rb) * 2048 + h * 256 + 128 * eh;
          bf16_t* op = RETO + (tok0 + 32 * rb) * 2048 + h * 256 + 128 * eh;
#pragma unroll
          for (int i = 0; i < 8; ++i) { const int x = lane + 64 * i, row = x >> 4, ch = x & 15;
              const u32x4 ov = *(const LAS u32x4*)(stg + row * 136 + ch * 8); const u32x4 g = *(const u32x4*)(gp + (size_t)row * 2048 + ch * 8);
              u32x4 w; w.x = cvt_pk(bf_lo(ov.x) * bf_lo(g.x), bf_hi(ov.x) * bf_hi(g.x)); w.y = cvt_pk(bf_lo(ov.y) * bf_lo(g.y), bf_hi(ov.y) * bf_hi(g.y));
              w.z = cvt_pk(bf_lo(ov.z) * bf_lo(g.z), bf_hi(ov.z) * bf_hi(g.z)); w.w = cvt_pk(bf_lo(ov.w) * bf_lo(g.w), bf_hi(ov.w) * bf_hi(g.w));
              *(u32x4*)(op + (size_t)row * 2048 + ch * 8) = w; } }
        if (!has) break;
        __syncthreads();
        it = itn;
    }
#undef RO_LOAD
    __syncthreads();
}

__device__ __forceinline__ void p5_router(const int WID_, const Params& p, LAS unsigned char* lds, int blk) {
    const int tid = TIDX, lane = tid & 63, r32 = lane & 31, hi = lane >> 5; const int wid = WID_;
    unsigned char* ws = p.ws; const float* H2 = (const float*)(ws + WS_H2);
    const int tok0 = blk * 64;
    LAS float* hc = (LAS float*)lds;
    LAS float* wc = (LAS float*)(lds + 65792);
    LAS float* ssr = (LAS float*)(lds + 98560);
    LAS int* cntl = (LAS int*)(lds + 98816);
    LAS int* gb = (LAS int*)(lds + 98944);
    LAS float* pl = (LAS float*)lds;
    if (tid < 32) cntl[tid] = 0;
    const int mt = wid & 1, ksub = wid >> 1;
    const int lrow = tid >> 3, lc0 = (tid & 7) * 32;
    f32x16 acc = (f32x16){}; float ssq = 0.f;
    for (int kc = 0; kc < 8; ++kc) {
#pragma unroll
        for (int j = 0; j < 8; ++j) { const f32x4 hv = *(const f32x4*)(H2 + (size_t)(tok0 + lrow) * DM + kc * 256 + lc0 + 4 * j); const f32x4 wv = *(const f32x4*)(p.ffn_norm_w + kc * 256 + lc0 + 4 * j);
            const f32x4 t = hv * wv; ssq += (hv[0] * hv[0] + hv[1] * hv[1]) + (hv[2] * hv[2] + hv[3] * hv[3]);
            LAS float* d = hc + lrow * 257 + lc0 + 4 * j; d[0] = t[0]; d[1] = t[1]; d[2] = t[2]; d[3] = t[3]; }
#pragma unroll
        for (int i = 0; i < 4; ++i) { const int x = tid + 512 * i, k = x >> 3, e4 = x & 7; *(LAS f32x4*)(wc + k * 32 + 4 * e4) = *(const f32x4*)(p.router_w + (size_t)(kc * 256 + k) * 32 + 4 * e4); }
        __syncthreads();
#pragma unroll 8
        for (int kk = 0; kk < 32; ++kk) { const int k0 = 64 * ksub + 2 * kk + hi; const float a = hc[(32 * mt + r32) * 257 + k0]; const float bb = wc[k0 * 32 + r32];
            acc = __builtin_amdgcn_mfma_f32_32x32x2f32(a, bb, acc, 0, 0, 0); }
        __syncthreads();
    }
    ssq += __shfl_xor(ssq, 1); ssq += __shfl_xor(ssq, 2); ssq += __shfl_xor(ssq, 4);
    if ((tid & 7) == 0) ssr[lrow] = ssq;
#pragma unroll
    for (int r = 0; r < 16; ++r) pl[wid * 1056 + crow(r, hi) * 33 + r32] = acc[r];
    __syncthreads();
    int te[4]; int lr[4]; float tw[4];
    if (tid < 64) {
        const int mt2 = tid >> 5, row = tid & 31; const float rs = rsqrtf(ssr[tid] * (1.0f / DM) + RMS_EPS);
        float v[32];
#pragma unroll
        for (int e = 0; e < 32; ++e) { float a = 0.f;
#pragma unroll
            for (int ks = 0; ks < 4; ++ks) a += pl[(mt2 + 2 * ks) * 1056 + row * 33 + e];
            v[e] = a * rs + p.router_b[e]; }
        float tv[4];
#pragma unroll
        for (int k = 0; k < 4; ++k) { float best = -INFINITY; int bi = 0;
#pragma unroll
            for (int e = 0; e < 32; ++e) if (v[e] > best) { best = v[e]; bi = e; }
#pragma unroll
            for (int e = 0; e < 32; ++e) if (e == bi) v[e] = -INFINITY;
            tv[k] = best; te[k] = bi; }
        float sum = 0.f;
#pragma unroll
        for (int k = 0; k < 4; ++k) { tw[k] = __expf(tv[k] - tv[0]); sum += tw[k]; }
        const float inv = 1.0f / sum;
#pragma unroll
        for (int k = 0; k < 4; ++k) { tw[k] *= inv; lr[k] = atomicAdd((int*)&cntl[te[k]], 1); }
    }
    __syncthreads();
    if (tid < 32) { const int c = cntl[tid]; int base = 0; if (c > 0) base = (int)atomicAdd((unsigned*)(ws + WS_CTL) + CW_CNT + tid, (unsigned)c); gb[tid] = base; }
    __syncthreads();
    if (tid < 64) { const int tok = tok0 + tid;
#pragma unroll
        for (int k = 0; k < 4; ++k) { const int rank = gb[te[k]] + lr[k];
            ((int*)(ws + WS_LIST))[(size_t)te[k] * NTOK + rank] = tok; ((int*)(ws + WS_TOKE))[tok * 4 + k] = te[k]; ((int*)(ws + WS_TOKR))[tok * 4 + k] = rank; ((float*)(ws + WS_TOKW))[tok * 4 + k] = tw[k]; } }
    for (int rr = 0; rr < 8; ++rr) { const int row = wid * 8 + rr; const float rs = rsqrtf(ssr[row] * (1.0f / DM) + RMS_EPS);
        const f32x4* hr = (const f32x4*)(H2 + (size_t)(tok0 + row) * DM) + lane; const f32x4* wr = (const f32x4*)p.ffn_norm_w + lane; u32x2* o8 = (u32x2*)((bf16_t*)(ws + WS_A2N) + (size_t)(tok0 + row) * DM) + lane;
#pragma unroll
        for (int j = 0; j < 8; ++j) { const f32x4 hv = hr[64 * j], wv = wr[64 * j];
            if constexpr (MOE_FP8 != 0) { ((unsigned*)(ws + WS_A2N + (size_t)(tok0 + row) * DM))[lane + 64 * j] = pk_fp8x4(hv[0] * rs * wv[0] * SC_X, hv[1] * rs * wv[1] * SC_X, hv[2] * rs * wv[2] * SC_X, hv[3] * rs * wv[3] * SC_X); }
            else { u32x2 o; o.x = cvt_pk(hv[0] * rs * wv[0], hv[1] * rs * wv[1]); o.y = cvt_pk(hv[2] * rs * wv[2], hv[3] * rs * wv[3]); o8[64 * j] = o; } } }
    __syncthreads();
}

__device__ __forceinline__ int moe_tables(const int WID_, const Params& p, LAS unsigned char* lds) {
    LAS int* cnt = (LAS int*)(lds + MISC_OFF + 64); LAS int* tile0 = (LAS int*)(lds + MISC_OFF + 192); LAS int* mte = (LAS int*)(lds + MISC_OFF + 512);
    const int tid = TIDX;
    if (tid < 32) cnt[tid] = (int)__hip_atomic_load((unsigned*)(p.ws + WS_CTL) + CW_CNT + tid, __ATOMIC_RELAXED, __HIP_MEMORY_SCOPE_AGENT);
    __syncthreads();
    if (tid == 0) { int t = 0; for (int e = 0; e < 32; ++e) { tile0[e] = t; const int nt = (cnt[e] + 255) >> 8; for (int j = 0; j < nt && t + j < MAXT; ++j) mte[t + j] = e; t += nt; if (t > MAXT) t = MAXT; } tile0[32] = t; }
    __syncthreads();
    return __builtin_amdgcn_readfirstlane(tile0[32]);
}

__device__ __forceinline__ void p8_final(const int WID_, const Params& p, LAS unsigned char* lds, int vcu, int G) {
    const int tid = TIDX, lane = tid & 63, wave = WID_;
    unsigned char* ws = p.ws; const LAS int* tile0 = (const LAS int*)(lds + MISC_OFF + 192);
    const int gw = vcu * 8 + wave, NGW = G * 8;
    const int* TE = (const int*)(ws + WS_TOKE); const int* TR = (const int*)(ws + WS_TOKR); const float* TW = (const float*)(ws + WS_TOKW);
    int m = gw; int e4[4], r4[4]; float w4[4];
    if (m < NTOK) {
#pragma unroll
        for (int k = 0; k < 4; ++k) { e4[k] = TE[m * 4 + k]; r4[k] = TR[m * 4 + k]; w4[k] = TW[m * 4 + k]; } }
    while (m < NTOK) {
        const f32x4* hr = (const f32x4*)((const float*)(ws + WS_H2) + (size_t)m * DM) + lane;
        f32x4 v[8]; u32x2 y[4][8];
#pragma unroll
        for (int j = 0; j < 8; ++j) v[j] = hr[64 * j];
#pragma unroll
        for (int k = 0; k < 4; ++k) { const size_t slot = (size_t)tile0[e4[k]] * 256 + r4[k]; const u32x2* yr = (const u32x2*)((const bf16_t*)(ws + WS_Y) + slot * DM) + lane;
#pragma unroll
            for (int j = 0; j < 8; ++j) y[k][j] = yr[64 * j]; }
        float wk[4];
#pragma unroll
        for (int k = 0; k < 4; ++k) wk[k] = w4[k];
        const int mn = m + NGW;
        if (mn < NTOK) {
#pragma unroll
            for (int k = 0; k < 4; ++k) { e4[k] = TE[mn * 4 + k]; r4[k] = TR[mn * 4 + k]; w4[k] = TW[mn * 4 + k]; } }
#pragma unroll
        for (int k = 0; k < 4; ++k)
#pragma unroll
            for (int j = 0; j < 8; ++j) { v[j][0] += wk[k] * bf_lo(y[k][j].x); v[j][1] += wk[k] * bf_hi(y[k][j].x); v[j][2] += wk[k] * bf_lo(y[k][j].y); v[j][3] += wk[k] * bf_hi(y[k][j].y); }
        float s = 0.f;
#pragma unroll
        for (int j = 0; j < 8; ++j) s += (v[j][0] * v[j][0] + v[j][1] * v[j][1]) + (v[j][2] * v[j][2] + v[j][3] * v[j][3]);
        const float rs = rsqrtf(wave_sum(s) * (1.0f / DM) + RMS_EPS);
        const f32x4* wr = (const f32x4*)p.final_norm_w + lane; f32x4* orow = (f32x4*)(p.out + (size_t)m * DM) + lane;
#pragma unroll
        for (int j = 0; j < 8; ++j) orow[64 * j] = v[j] * rs * wr[64 * j];
        m = mn;
    }
}

constexpr int NPHASE = 11;
__global__ void __launch_bounds__(512, 2) fwd(Params p) {
    extern __shared__ __attribute__((aligned(16))) unsigned char lds_raw[];
    LAS unsigned char* lds = (LAS unsigned char*)lds_raw;
    const int WID_ = __builtin_amdgcn_readfirstlane((int)threadIdx.x >> 6);
    const int tid = TIDX;
    const int G = gridDim.x; const int bx = blockIdx.x; const int vcu = (G % 8 == 0) ? (bx % 8) * (G / 8) + bx / 8 : bx;
    unsigned char* ws = p.ws;
    for (int u = tid; u < 1024; u += 512) ((LAS unsigned*)(lds + MISC_OFF))[u] = 0u;
    __syncthreads();
    XcdBarrier bar; bar.bar = (unsigned*)(ws + WS_CTL) + CW_BAR; bar.x = 0; bar.st = nullptr;
    const int lo = p.ph_lo, hi = p.ph_hi;
    if (hi - lo > 1) bar = xcd_barrier_post(WID_, (unsigned*)(ws + WS_CTL) + CW_BAR, (volatile LAS unsigned*)(lds + MISC_OFF));
#ifndef PHASE_MASK
#define PHASE_MASK 0x7ff
#endif
#define IN(k) (((PHASE_MASK >> (k)) & 1) && lo <= (k) && (k) < hi)
#ifndef DUP_MASK
#define DUP_MASK 0
#endif
#define REP(k) for (int rep_ = 0; rep_ < (((DUP_MASK >> (k)) & 1) ? 2 : 1); ++rep_)
#define SEAM(k) do { if (IN(k) && IN((k) + 1)) xcd_barrier(WID_, bar); } while (0)

    bf16_t* XN = (bf16_t*)(ws + WS_XN); bf16_t* RQ = (bf16_t*)(ws + WS_RQ); bf16_t* RK = (bf16_t*)(ws + WS_RK); bf16_t* RV = (bf16_t*)(ws + WS_RV); bf16_t* RG = (bf16_t*)(ws + WS_RG);
    bf16_t* SQ = (bf16_t*)(ws + WS_SQ); bf16_t* SK = (bf16_t*)(ws + WS_SK); bf16_t* SV = (bf16_t*)(ws + WS_SV); bf16_t* GATES = (bf16_t*)(ws + WS_GATES);
    bf16_t* BR = (bf16_t*)(ws + WS_BR); bf16_t* MIX = (bf16_t*)(ws + WS_MIX);

    if (IN(0)) REP(0) { p0_prologue(WID_, p, lds, vcu, G); }
    SEAM(0);
    if (IN(1)) REP(1) {
        StaticOrder S{64, 50, G, bx};
        EpiProj E{ws, p.gate_bias};
        pg8::gemm_phase<EpiProj, StaticOrder>(WID_, lds, XN, (const bf16_t*)(ws + WS_WIN_T), DM * 2, S, E);
    }
    SEAM(1);
    if (IN(2)) REP(2) {
        ret_u_phase(WID_, lds, RK, RV, (float*)(ws + WS_UT), vcu, G);
        swa_phase(WID_, lds, SQ, SK, SV, p.sinks, BR + (size_t)NTOK * DM, vcu, G);
    }
    SEAM(2);
    if (IN(3)) REP(3) { ret_scan(WID_, (const float*)(ws + WS_UT), (bf16_t*)(ws + WS_PNT), vcu, G); }
    SEAM(3);
    if (IN(4)) REP(4) {
        ret_out_phase(WID_, lds, RQ, RK, RV, RG, (const bf16_t*)(ws + WS_PNT), BR, vcu, G);
    }
    SEAM(4);
    if (IN(5)) REP(5) {
        MixOrder S{G, bx}; EpiMix E{GATES, MIX};
        pg8::gemm_phase<EpiMix, MixOrder>(WID_, lds, BR, (const bf16_t*)(ws + WS_WBR_T), DM * 2, S, E);
    }
    SEAM(5);
    if (IN(6)) REP(6) {
        StaticOrder S{64, 8, G, bx}; EpiResid E{p.x, (float*)(ws + WS_H2)};
        pg8::gemm_phase<EpiResid, StaticOrder>(WID_, lds, MIX, (const bf16_t*)(ws + WS_WO_T), DM * 2, S, E);
    }
    SEAM(6);
    if (IN(7)) { for (int blk = vcu; blk < NTOK / 64; blk += G) p5_router(WID_, p, lds, blk); }
    SEAM(7);
    if (IN(8)) REP(8) {
        const int T = moe_tables(WID_, p, lds);
        MoeOrder<true> S{T, 16, G, bx, (const LAS int*)(lds + MISC_OFF + 64), (const LAS int*)(lds + MISC_OFF + 192), (const LAS int*)(lds + MISC_OFF + 512), (const int*)(ws + WS_LIST)};
        EpiSwiglu E{p.b_gate_up, (bf16_t*)(ws + WS_ACT)};
        pg8::gemm_phase<EpiSwiglu, MoeOrder<true>, MOE_FP8 != 0>(WID_, lds, ws + WS_A2N, ws + WS_WGU_T, DM * MOE_EB, S, E);
    }
    SEAM(8);
    if (IN(9)) REP(9) {
        const int T = moe_tables(WID_, p, lds);
        MoeOrder<false> S{T, 8, G, bx, (const LAS int*)(lds + MISC_OFF + 64), (const LAS int*)(lds + MISC_OFF + 192), (const LAS int*)(lds + MISC_OFF + 512), (const int*)(ws + WS_LIST)};
        EpiDown E{p.b_down, (bf16_t*)(ws + WS_Y)};
        pg8::gemm_phase<EpiDown, MoeOrder<false>, MOE_FP8 != 0>(WID_, lds, ws + WS_ACT, ws + WS_WDN_T, DFF * MOE_EB, S, E);
    }
    SEAM(9);
    if (IN(10)) REP(10) { (void)moe_tables(WID_, p, lds); p8_final(WID_, p, lds, vcu, G); }
#undef IN
#undef SEAM
}

extern "C" void kernel_launch(void* const* d_in, const int* in_sizes, int n_in, void* d_out, int out_size, void* d_ws, size_t ws_size, hipStream_t stream) {
    static int grid = 0;
    if (grid == 0) {
        if (n_in != 17 || out_size != NTOK * DM || ws_size < WS_END) { fprintf(stderr, "kernel_launch: unexpected shapes (n_in %d, out %d, ws %zu, need %zu)\n", n_in, out_size, ws_size, (size_t)WS_END); grid = -1; return; }
        int dev = 0, cus = 0;
        if (hipGetDevice(&dev) != hipSuccess || hipDeviceGetAttribute(&cus, hipDeviceAttributeMultiprocessorCount, dev) != hipSuccess) { grid = -1; return; }
        if (hipFuncSetAttribute((const void*)fwd, hipFuncAttributeMaxDynamicSharedMemorySize, LDS_BYTES) != hipSuccess) { fprintf(stderr, "kernel_launch: hipFuncSetAttribute failed\n"); grid = -1; return; }
        int per_cu = 0;
        if (hipOccupancyMaxActiveBlocksPerMultiprocessor(&per_cu, (const void*)fwd, 512, LDS_BYTES) != hipSuccess || per_cu < 1) fprintf(stderr, "kernel_launch: occupancy query reports %d\n", per_cu);
        (void)hipGetLastError();
        grid = cus;
    }
    if (grid < 0) return;
    (void)hipMemsetAsync((char*)d_ws + WS_CTL, 0, CTL_BYTES, stream);
    Params p{};
    p.x = (const float*)d_in[0]; p.positions = (const int*)d_in[1]; p.attn_norm_w = (const float*)d_in[2]; p.w_in = (const float*)d_in[3]; p.gate_bias = (const float*)d_in[4];
    p.w_ret_out = (const float*)d_in[5]; p.w_swa_out = (const float*)d_in[6]; p.w_o = (const float*)d_in[7]; p.sinks = (const float*)d_in[8]; p.ffn_norm_w = (const float*)d_in[9];
    p.router_w = (const float*)d_in[10]; p.router_b = (const float*)d_in[11]; p.w_gate_up = (const float*)d_in[12]; p.b_gate_up = (const float*)d_in[13]; p.w_down = (const float*)d_in[14];
    p.b_down = (const float*)d_in[15]; p.final_norm_w = (const float*)d_in[16]; p.out = (float*)d_out; p.ws = (unsigned char*)d_ws;
#if MK_N_LAUNCHES == 1
    p.ph_lo = 0; p.ph_hi = NPHASE;
    hipLaunchKernelGGL(fwd, dim3(grid), dim3(512), LDS_BYTES, stream, p);
#else
    for (int k = 0; k < NPHASE; ++k) { p.ph_lo = k; p.ph_hi = k + 1; hipLaunchKernelGGL(fwd, dim3(grid), dim3(512), LDS_BYTES, stream, p); }
#endif
}
```
